# Optimizing an MI355X kernel written in HIP

```python
import functools
import numpy as np
import jax
import jax.numpy as jnp
from jax import lax

D_MODEL = 2048
BATCH = 8
SEQ = 2048
DEPTH = 1
DEC_BATCH = 32
DEC_SEQ = 4
PAST_LEN = 8192
PAGE_SIZE = 128

D_CONV = 1024
CONV_W = 3
N_HEADS = 16
N_KV_HEADS = 4
HEAD_DIM = 128
GROUP = N_HEADS // N_KV_HEADS
ROT_DIM = HEAD_DIM // 4
N_IDX_HEADS = 16
IDX_DIM = 64
IDX_ROT_DIM = IDX_DIM // 4
TOPK_MAX = 256
ROPE_THETA = 500000.0
D_FF = 5632
Q_BLOCK = 128
LN_EPS = 1e-5
DEEPNORM_ALPHA = (2.0 * DEPTH) ** 0.25
DEEPNORM_BETA = (8.0 * DEPTH) ** -0.25
D_Q = N_HEADS * HEAD_DIM
D_KV = N_KV_HEADS * HEAD_DIM
D_IQ = N_IDX_HEADS * IDX_DIM
SPLIT_SIZES = (D_CONV, D_CONV, D_CONV, D_Q, D_KV, D_KV, D_IQ, IDX_DIM, N_IDX_HEADS, D_MODEL, D_MODEL)
D_IN = sum(SPLIT_SIZES)

kernel_name = 'dsa_shortconv_parallel_hybrid_step'


def _layer_norm(x, g, b):
    xf = x.astype(jnp.float32)
    mu = jnp.mean(xf, axis=-1, keepdims=True)
    var = jnp.mean(jnp.square(xf - mu), axis=-1, keepdims=True)
    y = (xf - mu) * lax.rsqrt(var + LN_EPS) * g.astype(jnp.float32) + b.astype(jnp.float32)
    return y.astype(x.dtype)


def _partial_rope(x, pos, rot_dim):
    half = rot_dim // 2
    inv_freq = ROPE_THETA ** (-jnp.arange(half, dtype=jnp.float32) / half)
    ang = pos.astype(jnp.float32)[:, None] * inv_freq[None, :]
    cos = jnp.cos(ang)[None, :, None, :]
    sin = jnp.sin(ang)[None, :, None, :]
    xr = x[..., :rot_dim].astype(jnp.float32)
    x1, x2 = xr[..., :half], xr[..., half:]
    rot = jnp.concatenate([x1 * cos - x2 * sin, x2 * cos + x1 * sin], axis=-1).astype(x.dtype)
    return jnp.concatenate([rot, x[..., rot_dim:]], axis=-1)


def _causal_dwconv(u, hist, w):
    T = u.shape[1]
    ext = jnp.concatenate([hist, u], axis=1)
    y = ext[:, 0:T] * w[0]
    for j in range(1, CONV_W):
        y = y + ext[:, j:j + T] * w[j]
    return y, ext[:, -(CONV_W - 1):]


def _index_scores(iq, ik, iw):
    s = jnp.einsum('bthd,bsd->bths', iq, ik, preferred_element_type=jnp.float32)
    return jnp.einsum('bths,bth->bts', jax.nn.relu(s * IDX_DIM ** -0.5), iw.astype(jnp.float32))


def _gather_rows(rows, idx):
    return jax.vmap(lambda r, i: r[i])(rows, idx)


def _sparse_attend(q, k_sel, v_sel, valid):
    B, T = q.shape[:2]
    qg = q.reshape(B, T, N_KV_HEADS, GROUP, HEAD_DIM)
    logits = jnp.einsum('btkgd,btskd->btkgs', qg, k_sel, preferred_element_type=jnp.float32) * HEAD_DIM ** -0.5
    logits = jnp.where(valid[:, :, None, None, :], logits, -jnp.inf)
    p = jax.nn.softmax(logits, axis=-1).astype(v_sel.dtype)
    o = jnp.einsum('btkgs,btskd->btkgd', p, v_sel)
    return o.reshape(B, T, D_Q)


def _prompt_attention(q, k, v, iq, ik, iw):
    B, T = q.shape[:2]
    topk = min(TOPK_MAX, T // 4)
    key_pos = jnp.arange(T, dtype=jnp.int32)

    def block(i):
        start = i * Q_BLOCK
        qb = lax.dynamic_slice_in_dim(q, start, Q_BLOCK, axis=1)
        iqb = lax.dynamic_slice_in_dim(iq, start, Q_BLOCK, axis=1)
        iwb = lax.dynamic_slice_in_dim(iw, start, Q_BLOCK, axis=1)
        qpos = start + jnp.arange(Q_BLOCK, dtype=jnp.int32)
        scores = _index_scores(iqb, ik, iwb)
        scores = jnp.where((key_pos[None, :] <= qpos[:, None])[None], scores, -jnp.inf)
        _, idx = lax.top_k(scores, topk)
        valid = idx <= qpos[None, :, None]
        return _sparse_attend(qb, _gather_rows(k, idx), _gather_rows(v, idx), valid)

    out = lax.map(block, jnp.arange(T // Q_BLOCK, dtype=jnp.int32))
    return jnp.swapaxes(out, 0, 1).reshape(B, T, D_Q)


def _sample_attention(q, k, v, iq, ik, iw, cache_k, cache_v, cache_idx_k, page_table, layer):
    B, T = q.shape[:2]
    n_pages = PAST_LEN // PAGE_SIZE
    L = PAST_LEN + T
    topk = min(TOPK_MAX, L // 4)
    ik_past = cache_idx_k[layer, page_table].reshape(B, n_pages * PAGE_SIZE, IDX_DIM)
    ik_all = jnp.concatenate([ik_past, ik], axis=1)
    qpos = PAST_LEN + jnp.arange(T, dtype=jnp.int32)
    scores = _index_scores(iq, ik_all, iw)
    scores = jnp.where((jnp.arange(L, dtype=jnp.int32)[None, :] <= qpos[:, None])[None], scores, -jnp.inf)
    _, idx = lax.top_k(scores, topk)
    valid = idx <= qpos[None, :, None]
    in_past = (idx < PAST_LEN)[..., None, None]
    pidx = jnp.minimum(idx, PAST_LEN - 1)
    phys = jax.vmap(lambda pt, i: pt[i])(page_table, pidx // PAGE_SIZE)
    off = pidx % PAGE_SIZE
    nidx = jnp.clip(idx - PAST_LEN, 0, T - 1)
    k_sel = jnp.where(in_past, cache_k[layer, phys, off], _gather_rows(k, nidx))
    v_sel = jnp.where(in_past, cache_v[layer, phys, off], _gather_rows(v, nidx))
    return _sparse_attend(q, k_sel, v_sel, valid)


def _layer(x, pos, attend, conv_a_hist, ffn_hist, w_in, idx_k_norm_g, idx_k_norm_b, conv_a_w, w_a_out,
           w_attn_out, w_mix_out, ln1_g, ln1_b, w_up, w_gate, conv_ffn_w, conv_ffn_b, w_down, ln2_g, ln2_b):
    B, T, _ = x.shape
    z = jnp.einsum('btd,de->bte', x, w_in)
    points = [int(p) for p in np.cumsum(SPLIT_SIZES)[:-1]]
    cb, cc, ch, q, k, v, iq, ik, iw, ga, gb = jnp.split(z, points, axis=-1)
    y_conv, new_conv_a = _causal_dwconv(cc * ch, conv_a_hist, conv_a_w)
    y_a = jnp.einsum('btc,cd->btd', cb * y_conv, w_a_out)
    q = _partial_rope(q.reshape(B, T, N_HEADS, HEAD_DIM), pos, ROT_DIM)
    k = _partial_rope(k.reshape(B, T, N_KV_HEADS, HEAD_DIM), pos, ROT_DIM)
    v = v.reshape(B, T, N_KV_HEADS, HEAD_DIM)
    iq = _partial_rope(iq.reshape(B, T, N_IDX_HEADS, IDX_DIM), pos, IDX_ROT_DIM)
    ik = _partial_rope(_layer_norm(ik, idx_k_norm_g, idx_k_norm_b)[:, :, None, :], pos, IDX_ROT_DIM)[:, :, 0, :]
    iw = iw * N_IDX_HEADS ** -0.5
    y_b = jnp.einsum('bte,ed->btd', attend(q, k, v, iq, ik, iw), w_attn_out)
    m = jax.nn.sigmoid(ga) * y_a + jax.nn.sigmoid(gb) * y_b
    h = _layer_norm(DEEPNORM_ALPHA * x + jnp.einsum('btd,de->bte', m, w_mix_out), ln1_g, ln1_b)
    u = jnp.einsum('btd,df->btf', h, w_up)
    g = jnp.einsum('btd,df->btf', h, w_gate)
    uc, new_conv_ffn = _causal_dwconv(u, ffn_hist, conv_ffn_w)
    f = jnp.einsum('btf,fd->btd', jax.nn.gelu(uc + conv_ffn_b) * g, w_down)
    out = _layer_norm(DEEPNORM_ALPHA * h + f, ln2_g, ln2_b)
    return out, k, v, ik, new_conv_a, new_conv_ffn


def setup_inputs(seed: int = 0) -> dict:
    key = jax.random.key(seed)
    ks = jax.random.split(key, 26)
    n_pages = PAST_LEN // PAGE_SIZE
    n_phys = (DEC_BATCH * n_pages * 5) // 4

    def nrm(k, shape, scale):
        return jax.random.normal(k, shape, jnp.float32) * scale

    x_prompt = nrm(ks[0], (BATCH, SEQ, D_MODEL), 1.0)
    x_sample = nrm(ks[1], (DEC_BATCH, DEC_SEQ, D_MODEL), 1.0)
    cache_k = nrm(ks[2], (DEPTH, n_phys, PAGE_SIZE, N_KV_HEADS, HEAD_DIM), 1.0)
    cache_v = nrm(ks[3], (DEPTH, n_phys, PAGE_SIZE, N_KV_HEADS, HEAD_DIM), 1.0)
    cache_idx_k = nrm(ks[4], (DEPTH, n_phys, PAGE_SIZE, IDX_DIM), 1.0)
    state_conv_a = nrm(ks[5], (DEPTH, DEC_BATCH, CONV_W - 1, D_CONV), 1.0)
    state_conv_ffn = nrm(ks[6], (DEPTH, DEC_BATCH, CONV_W - 1, D_FF), 1.0)
    page_table = jax.random.permutation(ks[7], n_phys)[:DEC_BATCH * n_pages].reshape(DEC_BATCH, n_pages).astype(jnp.int32)
    col_scale = jnp.concatenate([
        jnp.ones((3 * D_CONV + D_Q + D_KV,), jnp.float32),
        jnp.full((D_KV,), DEEPNORM_BETA, dtype=jnp.float32),
        jnp.ones((D_IQ + IDX_DIM + N_IDX_HEADS + 2 * D_MODEL,), jnp.float32)])
    w_in = nrm(ks[8], (DEPTH, D_MODEL, D_IN), D_MODEL ** -0.5) * col_scale
    idx_k_norm_g = 1.0 + nrm(ks[9], (DEPTH, IDX_DIM), 0.02)
    idx_k_norm_b = nrm(ks[10], (DEPTH, IDX_DIM), 0.02)
    conv_a_w = nrm(ks[11], (DEPTH, CONV_W, D_CONV), CONV_W ** -0.5)
    w_a_out = nrm(ks[12], (DEPTH, D_CONV, D_MODEL), DEEPNORM_BETA * D_CONV ** -0.5)
    w_attn_out = nrm(ks[13], (DEPTH, D_Q, D_MODEL), DEEPNORM_BETA * D_Q ** -0.5)
    w_mix_out = nrm(ks[14], (DEPTH, D_MODEL, D_MODEL), DEEPNORM_BETA * D_MODEL ** -0.5)
    ln1_g = 1.0 + nrm(ks[15], (DEPTH, D_MODEL), 0.02)
    ln1_b = nrm(ks[16], (DEPTH, D_MODEL), 0.02)
    w_up = nrm(ks[17], (DEPTH, D_MODEL, D_FF), D_MODEL ** -0.5)
    w_gate = nrm(ks[18], (DEPTH, D_MODEL, D_FF), D_MODEL ** -0.5)
    conv_ffn_w = nrm(ks[19], (DEPTH, CONV_W, D_FF), CONV_W ** -0.5)
    conv_ffn_b = nrm(ks[20], (DEPTH, D_FF), 0.02)
    w_down = nrm(ks[21], (DEPTH, D_FF, D_MODEL), DEEPNORM_BETA * D_FF ** -0.5)
    ln2_g = 1.0 + nrm(ks[22], (DEPTH, D_MODEL), 0.02)
    ln2_b = nrm(ks[23], (DEPTH, D_MODEL), 0.02)
    return {'x_prompt': x_prompt, 'x_sample': x_sample, 'cache_k': cache_k, 'cache_v': cache_v,
            'cache_idx_k': cache_idx_k, 'state_conv_a': state_conv_a, 'state_conv_ffn': state_conv_ffn,
            'page_table': page_table, 'w_in': w_in, 'idx_k_norm_g': idx_k_norm_g, 'idx_k_norm_b': idx_k_norm_b,
            'conv_a_w': conv_a_w, 'w_a_out': w_a_out, 'w_attn_out': w_attn_out, 'w_mix_out': w_mix_out,
            'ln1_g': ln1_g, 'ln1_b': ln1_b, 'w_up': w_up, 'w_gate': w_gate, 'conv_ffn_w': conv_ffn_w,
            'conv_ffn_b': conv_ffn_b, 'w_down': w_down, 'ln2_g': ln2_g, 'ln2_b': ln2_b}


def reference(x_prompt, x_sample, cache_k, cache_v, cache_idx_k, state_conv_a, state_conv_ffn, page_table,
              w_in, idx_k_norm_g, idx_k_norm_b, conv_a_w, w_a_out, w_attn_out, w_mix_out, ln1_g, ln1_b,
              w_up, w_gate, conv_ffn_w, conv_ffn_b, w_down, ln2_g, ln2_b):
    bp, tp = x_prompt.shape[:2]
    bs, ts = x_sample.shape[:2]
    pos_p = jnp.arange(tp, dtype=jnp.int32)
    pos_s = PAST_LEN + jnp.arange(ts, dtype=jnp.int32)
    hp, hs = x_prompt, x_sample
    kp, vp, ikp, cap, cfp = [], [], [], [], []
    kss, vss, iks, cas, cfs = [], [], [], [], []
    for l in range(DEPTH):
        wts = (w_in[l], idx_k_norm_g[l], idx_k_norm_b[l], conv_a_w[l], w_a_out[l], w_attn_out[l], w_mix_out[l],
               ln1_g[l], ln1_b[l], w_up[l], w_gate[l], conv_ffn_w[l], conv_ffn_b[l], w_down[l], ln2_g[l], ln2_b[l])
        zero_a = jnp.zeros((bp, CONV_W - 1, D_CONV), hp.dtype)
        zero_f = jnp.zeros((bp, CONV_W - 1, D_FF), hp.dtype)
        hp, k1, v1, ik1, ca1, cf1 = _layer(hp, pos_p, _prompt_attention, zero_a, zero_f, *wts)
        kp.append(k1); vp.append(v1); ikp.append(ik1); cap.append(ca1); cfp.append(cf1)
        attend_s = functools.partial(_sample_attention, cache_k=cache_k, cache_v=cache_v,
                                     cache_idx_k=cache_idx_k, page_table=page_table, layer=l)
        hs, k2, v2, ik2, ca2, cf2 = _layer(hs, pos_s, attend_s, state_conv_a[l], state_conv_ffn[l], *wts)
        kss.append(k2); vss.append(v2); iks.append(ik2); cas.append(ca2); cfs.append(cf2)
    return (hp, hs, jnp.stack(kp), jnp.stack(vp), jnp.stack(ikp), jnp.stack(cap), jnp.stack(cfp),
            jnp.stack(kss), jnp.stack(vss), jnp.stack(iks), jnp.stack(cas), jnp.stack(cfs))
```

```cpp
#include <hip/hip_runtime.h>
#include <cstdio>
#include <cstdint>
namespace pg8 {
#define PG8_LAS __attribute__((address_space(3)))
typedef unsigned short bf16_t;
typedef short bf16x8 __attribute__((ext_vector_type(8)));
typedef float f32x4 __attribute__((ext_vector_type(4)));
typedef unsigned u32x4 __attribute__((ext_vector_type(4)));
constexpr int BM = 256, BK = 64, HALF = 128, HTB = HALF * BK * 2  , STAGE_BYTES = 8 * HTB, NXCD = 8, WGM = 8;

__host__ __device__ __forceinline__ int lds_byte(int r, int c) { const int st = (r >> 4) * 2 + (c >> 5), rr = r & 15, cc = c & 31, ob = rr * 64 + cc * 2; return st * 1024 + (ob ^ (((ob >> 9) & 1) << 5)); }
__host__ __device__ __forceinline__ void stage_rc(int b, int& R, int& C) { const int st = b / 1024, sb = b % 1024, swz = sb ^ (((sb >> 9) & 1) << 5); R = (st >> 1) * 16 + swz / 64; C = (st & 1) * 32 + (swz % 64) / 2; }
__host__ __device__ __forceinline__ int perm32(int rho) { const int n = rho >> 4, i = rho & 15; return 8 * (i >> 2) + 4 * n + (i & 3); }

struct Unit { int pm, pn; };
struct Gemm { const bf16_t* A; const bf16_t* Bt; int M, N, K; };

struct StaticOrder {
    int nM, nN, nwg, G, c;
    __host__ __device__ void init(int M, int N, int G_, int c_) { nM = M / BM; nN = N / BM; nwg = nM * nN; G = G_; c = c_; }
    __host__ __device__ bool next(int i, Unit& u) const {
        const long L = (long)i * G + c; if (L >= nwg) return false;
        int wgid = (int)L; { const int q = nwg / NXCD, r = nwg % NXCD, xcd = wgid % NXCD, off = wgid / NXCD; wgid = (xcd < r ? xcd * (q + 1) : r * (q + 1) + (xcd - r) * q) + off; }
        const int nig = WGM * nN, gid = wgid / nig, fm = gid * WGM, gsz = (nM - fm) < WGM ? (nM - fm) : WGM;
        u.pm = fm + ((wgid % nig) % gsz); u.pn = (wgid % nig) / gsz; return true;
    }
    __device__ __forceinline__ void a_ready(const Unit&) const {}
    __device__ __forceinline__ void done(const Unit&) const {}
};

__device__ __forceinline__ unsigned cvt_pk_bf16(float lo, float hi) { unsigned r; asm volatile("v_cvt_pk_bf16_f32 %0, %1, %2" : "=v"(r) : "v"(lo), "v"(hi)); return r; }
template <class Epi, class Sched, bool ALIGN_EPI = false, bool SP2 = false>
__device__ __forceinline__ void gemm_phase(PG8_LAS unsigned char* lds, const Gemm g, const Sched& S, const Epi& E) {
    const int tid = threadIdx.x, wid = __builtin_amdgcn_readfirstlane(tid >> 6), lane = tid & 63, wr = wid >> 2, wc = wid & 3, fr = lane & 15, fq = lane >> 4;
    const int K = g.K, nt = K / BK;
    unsigned voffA[2], voffB[2];
#pragma unroll
    for (int i = 0; i < 2; ++i) { int R, C; stage_rc(tid * 16 + i * 8192, R, C); const int Rb = Epi::PERM ? ((R & ~31) + perm32(R & 31)) : R;
        voffA[i] = (unsigned)(R * K + C) * 2u; voffB[i] = (unsigned)(Rb * K + C) * 2u; }
    const size_t kstep = (size_t)(BK * 2);
    const size_t hstep = (size_t)HALF * K * 2;
    const size_t tstep = 2 * hstep;
    const unsigned ldsw = (unsigned)wid * 1024u;
    const int aoff = lds_byte(wr * 64 + fr, fq * 8), boff = lds_byte(wc * 32 + fr, fq * 8);
#define PG8_SA(b, h) (((b) * 2 + (h)) * HTB)
#define PG8_SB(b, h) ((4 + (b) * 2 + (h)) * HTB)
#define PG8_STAGE(bufoff, gbase, voff) do { _Pragma("unroll") for (int _i = 0; _i < 2; ++_i) \
        __builtin_amdgcn_global_load_lds((const unsigned*)((const char*)(gbase) + (voff)[_i]), (PG8_LAS unsigned*)(lds + (bufoff) + ldsw + _i * 8192), 16, 0, 0); } while (0)
#define PG8_LDA(dst, b, h) do { _Pragma("unroll") for (int m = 0; m < 4; ++m) _Pragma("unroll") for (int k = 0; k < 2; ++k) dst[m][k] = *(const PG8_LAS bf16x8*)(lds + PG8_SA(b, h) + aoff + m * 2048 + k * 1024); } while (0)
#define PG8_LDB(dst, b, h) do { _Pragma("unroll") for (int n = 0; n < 2; ++n) _Pragma("unroll") for (int k = 0; k < 2; ++k) dst[n][k] = *(const PG8_LAS bf16x8*)(lds + PG8_SB(b, h) + boff + n * 2048 + k * 1024); } while (0)
#define PG8_MMA(ai, bj, At, Bt) do { __builtin_amdgcn_s_setprio(1); _Pragma("unroll") for (int m = 0; m < 4; ++m) _Pragma("unroll") for (int n = 0; n < 2; ++n) _Pragma("unroll") for (int k = 0; k < 2; ++k) \
        acc[ai][bj][m][n] = __builtin_amdgcn_mfma_f32_16x16x32_bf16(Bt[n][k], At[m][k], acc[ai][bj][m][n], 0, 0, 0); __builtin_amdgcn_s_setprio(0); } while (0)
#define PG8_WAIT_V(n) asm volatile("s_waitcnt vmcnt(" #n ")" ::: "memory")
#define PG8_WAIT_L(n) asm volatile("s_waitcnt lgkmcnt(" #n ")" ::: "memory")
#define PG8_BAR __builtin_amdgcn_s_barrier()
#define PG8_SCHED __builtin_amdgcn_sched_barrier(0)
    Unit cur, nxt; int ui = 0;
    if (!S.next(0, cur)) return;
    f32x4 acc[2][2][4][2];
#pragma unroll
    for (int a = 0; a < 2; ++a)
#pragma unroll
        for (int b = 0; b < 2; ++b)
#pragma unroll
            for (int m = 0; m < 4; ++m)
#pragma unroll
                for (int n = 0; n < 2; ++n) acc[a][b][m][n] = (f32x4){0.f, 0.f, 0.f, 0.f};
    bf16x8 At[4][2], B0[2][2], B1[2][2];
    const char* cA = (const char*)g.A + (size_t)cur.pm * tstep; const char* cB = (const char*)g.Bt + (size_t)cur.pn * tstep;
    S.a_ready(cur);
    if constexpr (SP2) {
        PG8_STAGE(PG8_SB(0, 0), cB, voffB); PG8_STAGE(PG8_SB(0, 1), cB + hstep, voffB); PG8_STAGE(PG8_SA(0, 0), cA, voffA); PG8_STAGE(PG8_SA(0, 1), cA + hstep, voffA);
        if (wr == 1) PG8_BAR;
        PG8_WAIT_V(2); PG8_BAR;
        PG8_STAGE(PG8_SB(1, 0), cB + kstep, voffB); PG8_STAGE(PG8_SA(1, 0), cA + kstep, voffA); PG8_STAGE(PG8_SB(1, 1), cB + hstep + kstep, voffB);
        PG8_WAIT_V(6); PG8_BAR;
    } else {
        PG8_STAGE(PG8_SB(0, 0), cB, voffB); PG8_STAGE(PG8_SA(0, 0), cA, voffA); PG8_STAGE(PG8_SB(0, 1), cB + hstep, voffB); PG8_STAGE(PG8_SA(0, 1), cA + hstep, voffA);
        if (wr == 1) PG8_BAR;
        PG8_WAIT_V(4); PG8_BAR;
        PG8_STAGE(PG8_SB(1, 0), cB + kstep, voffB); PG8_STAGE(PG8_SA(1, 0), cA + kstep, voffA); PG8_STAGE(PG8_SB(1, 1), cB + hstep + kstep, voffB);
        PG8_WAIT_V(6); PG8_BAR;
    }
    for (;;) {
        const bool has_next = S.next(ui + 1, nxt);
        const char* nA = has_next ? (const char*)g.A + (size_t)nxt.pm * tstep : cA; const char* nB = has_next ? (const char*)g.Bt + (size_t)nxt.pn * tstep : cB;
        for (int t = 0; t < nt; t += 2) {
            const bool last = (t == nt - 2);
            const char* a1 = cA + (size_t)(t + 1) * kstep;
            const char* a2 = last ? nA : cA + (size_t)(t + 2) * kstep; const char* b2 = last ? nB : cB + (size_t)(t + 2) * kstep;
            const char* a3 = a2 + kstep; const char* b3 = b2 + kstep;
            if (last && has_next) S.a_ready(nxt);
            if constexpr (SP2) {
            PG8_LDB(B0, 0, 0); PG8_LDB(B1, 0, 1); PG8_SCHED; PG8_LDA(At, 0, 0); PG8_STAGE(PG8_SA(1, 1), a1 + hstep, voffA);
            PG8_WAIT_V(8); PG8_WAIT_L(0); PG8_BAR; PG8_MMA(0, 0, At, B0); PG8_MMA(0, 1, At, B1); PG8_BAR; PG8_SCHED;
            PG8_LDA(At, 0, 1); PG8_STAGE(PG8_SB(0, 0), b2, voffB); PG8_STAGE(PG8_SB(0, 1), b2 + hstep, voffB); PG8_STAGE(PG8_SA(0, 0), a2, voffA);
            PG8_WAIT_V(8); PG8_WAIT_L(0); PG8_BAR; PG8_MMA(1, 0, At, B0); PG8_MMA(1, 1, At, B1); PG8_BAR; PG8_SCHED;
            PG8_LDB(B0, 1, 0); PG8_LDB(B1, 1, 1); PG8_SCHED; PG8_LDA(At, 1, 0); PG8_STAGE(PG8_SA(0, 1), a2 + hstep, voffA);
            PG8_WAIT_V(8); PG8_WAIT_L(0); PG8_BAR; PG8_MMA(0, 0, At, B0); PG8_MMA(0, 1, At, B1); PG8_BAR; PG8_SCHED;
            PG8_LDA(At, 1, 1); PG8_STAGE(PG8_SB(1, 0), b3, voffB); PG8_STAGE(PG8_SB(1, 1), b3 + hstep, voffB); PG8_STAGE(PG8_SA(1, 0), a3, voffA);
            PG8_WAIT_V(8); PG8_WAIT_L(0); PG8_BAR; PG8_MMA(1, 0, At, B0); PG8_MMA(1, 1, At, B1); PG8_BAR; PG8_SCHED;
            } else {
            PG8_LDB(B0, 0, 0); PG8_SCHED; PG8_LDA(At, 0, 0); PG8_STAGE(PG8_SA(1, 1), a1 + hstep, voffA);
            PG8_WAIT_L(8); PG8_BAR; PG8_WAIT_L(0); PG8_MMA(0, 0, At, B0); PG8_BAR; PG8_SCHED;
            PG8_LDB(B1, 0, 1); PG8_STAGE(PG8_SB(0, 0), b2, voffB);
            PG8_BAR; PG8_WAIT_L(0); PG8_MMA(0, 1, At, B1); PG8_BAR;
            PG8_LDA(At, 0, 1); PG8_STAGE(PG8_SA(0, 0), a2, voffA);
            PG8_BAR; PG8_WAIT_L(0); PG8_MMA(1, 0, At, B0); PG8_BAR; PG8_SCHED;
            PG8_STAGE(PG8_SB(0, 1), b2 + hstep, voffB);
            PG8_WAIT_V(6); PG8_BAR; PG8_MMA(1, 1, At, B1); PG8_BAR;
            PG8_LDB(B0, 1, 0); PG8_SCHED; PG8_LDA(At, 1, 0); PG8_STAGE(PG8_SA(0, 1), a2 + hstep, voffA);
            PG8_WAIT_L(8); PG8_BAR; PG8_WAIT_L(0); PG8_MMA(0, 0, At, B0); PG8_BAR; PG8_SCHED;
            PG8_LDB(B1, 1, 1); PG8_STAGE(PG8_SB(1, 0), b3, voffB);
            PG8_BAR; PG8_WAIT_L(0); PG8_MMA(0, 1, At, B1); PG8_BAR;
            PG8_LDA(At, 1, 1); PG8_STAGE(PG8_SA(1, 0), a3, voffA);
            PG8_BAR; PG8_WAIT_L(0); PG8_MMA(1, 0, At, B0); PG8_BAR; PG8_SCHED;
            PG8_STAGE(PG8_SB(1, 1), b3 + hstep, voffB);
            PG8_WAIT_V(6); PG8_BAR; PG8_MMA(1, 1, At, B1); PG8_BAR;
            }
        }
        if constexpr (ALIGN_EPI) { if (wr == 0) PG8_BAR; }
        if constexpr (!Epi::AFTER_DRAIN) { E(acc, cur, wr, wc, fr, fq); S.done(cur); }
        if (!has_next) break;
#pragma unroll
        for (int a = 0; a < 2; ++a)
#pragma unroll
            for (int b = 0; b < 2; ++b)
#pragma unroll
                for (int m = 0; m < 4; ++m)
#pragma unroll
                    for (int n = 0; n < 2; ++n) acc[a][b][m][n] = (f32x4){0.f, 0.f, 0.f, 0.f};
        cur = nxt; cA = nA; cB = nB; ++ui;
        if constexpr (ALIGN_EPI) { if (wr == 1) PG8_BAR; }
    }
    PG8_WAIT_V(0);
    if constexpr (!ALIGN_EPI) { if (wr == 0) PG8_BAR; }
    PG8_BAR;
    if constexpr (Epi::AFTER_DRAIN) { E.fused(acc, cur, wr, wc, fr, fq, lds, wid, lane); S.done(cur); }
#undef PG8_SA
#undef PG8_SB
#undef PG8_STAGE
#undef PG8_LDA
#undef PG8_LDB
#undef PG8_MMA
#undef PG8_WAIT_V
#undef PG8_WAIT_L
#undef PG8_BAR
#undef PG8_SCHED
}
}

#ifndef MK_N_LAUNCHES
#define MK_N_LAUNCHES 0
#endif
constexpr int NWAVES = 8;
constexpr int N_PHASES = 12;

constexpr int DM = 2048, NBATCH = 8, SEQ = 2048, MP = NBATCH * SEQ, DECB = 32, DECS = 4, MS = DECB * DECS, MALL = MP + MS;
constexpr int PAST = 8192, PAGE = 128, NPAGES = PAST / PAGE;
constexpr int DCONV = 1024, NKV = 4, HD = 128, NIH = 16, IDD = 64, TOPK = 256, DFF = 5632;
constexpr int DQ = 2048, DKV = 512, DIQ = 1024, DIN = 11344;
constexpr int NZ = 11264;
constexpr int NUG = 2 * DFF;
constexpr int SSC_PITCH = 8256;
constexpr float LN_EPS = 1e-5f;
constexpr float ALPHA = 1.189207115002721f;

constexpr size_t O_Y = 0, O_KP = 33816576, O_VP = 42205184, O_IKP = 50593792, O_CAP = 51642368, O_CFP = 51658752,
                 O_KS = 51748864, O_VS = 51814400, O_IKS = 51879936, O_CAS = 51888128, O_CFS = 51953664, O_END = 52314112;

constexpr size_t MiB = 1u << 20;
constexpr size_t WS_CTL = 0, CTL_ZERO_BYTES = 1 * MiB;
constexpr size_t WS_ROPEA = 1 * MiB, WS_ROPEB = 1 * MiB + 512 * 1024;
constexpr size_t WS_WIN = 2 * MiB, WS_WAOUT = 48 * MiB, WS_WATTN = 52 * MiB, WS_WMIX = 60 * MiB, WS_WUG = 68 * MiB, WS_WDOWN = 112 * MiB;
constexpr size_t WS_XB = 136 * MiB, WS_CB = 202 * MiB, WS_CCH = 235 * MiB, WS_QB = 268 * MiB, WS_KB = 334 * MiB, WS_VB = 351 * MiB, WS_IQB = 368 * MiB;
constexpr size_t WS_IKB = 401 * MiB, WS_IW = 404 * MiB, WS_SGA = 406 * MiB, WS_SGB = 472 * MiB, WS_A2 = 538 * MiB, WS_MA = 571 * MiB, WS_OB = 637 * MiB, WS_MB = 703 * MiB;
constexpr size_t WS_PRE1 = 769 * MiB, WS_X1 = 899 * MiB, WS_X1B = 1029 * MiB, WS_UG = 1095 * MiB, WS_HC = 1451 * MiB, WS_ZS = 1629 * MiB, WS_YAS = 1635 * MiB;
constexpr size_t WS_SSC = 1636 * MiB, WS_MASK = 1641 * MiB, WS_END = 1645 * MiB;
constexpr int CW_BAR = 4096;

constexpr int RING_BYTES = 131072;
constexpr int LDSCTL_OFF = RING_BYTES, MISC_OFF = LDSCTL_OFF + 320;
constexpr int LDS_BYTES = 147456;

#define GAS __attribute__((address_space(1)))
#define LAS __attribute__((address_space(3)))
typedef unsigned short bf16;
typedef unsigned v4u __attribute__((ext_vector_type(4)));
typedef unsigned v2u __attribute__((ext_vector_type(2)));
typedef float f32x4 __attribute__((ext_vector_type(4)));
typedef float f32x2 __attribute__((ext_vector_type(2)));
typedef short bf16x8 __attribute__((ext_vector_type(8)));
#define LDS_WAIT() asm volatile("s_waitcnt lgkmcnt(0)" ::: "memory")
#define VM_WAIT() asm volatile("s_waitcnt vmcnt(0)" ::: "memory")
__device__ __forceinline__ unsigned f2bf(float f) { unsigned u = __builtin_bit_cast(unsigned, f); return (u + 0x7fffu + ((u >> 16) & 1u)) >> 16; }
__device__ __forceinline__ unsigned pk2(float lo, float hi) { return f2bf(lo) | (f2bf(hi) << 16); }
__device__ __forceinline__ float bflo(unsigned w) { return __builtin_bit_cast(float, w << 16); }
__device__ __forceinline__ float bfhi(unsigned w) { return __builtin_bit_cast(float, w & 0xffff0000u); }
__device__ __forceinline__ float bf1(bf16 h) { return __builtin_bit_cast(float, ((unsigned)h) << 16); }
__device__ __forceinline__ void unpack8(v4u w, float (&f)[8]) { f[0] = bflo(w.x); f[1] = bfhi(w.x); f[2] = bflo(w.y); f[3] = bfhi(w.y); f[4] = bflo(w.z); f[5] = bfhi(w.z); f[6] = bflo(w.w); f[7] = bfhi(w.w); }
__device__ __forceinline__ v4u pack8(const float (&f)[8]) { v4u w; w.x = pk2(f[0], f[1]); w.y = pk2(f[2], f[3]); w.z = pk2(f[4], f[5]); w.w = pk2(f[6], f[7]); return w; }
__device__ __forceinline__ void zero8(float (&f)[8]) { f[0] = f[1] = f[2] = f[3] = f[4] = f[5] = f[6] = f[7] = 0.f; }
__device__ __forceinline__ float sigmoidf_(float x) { return 1.0f / (1.0f + __expf(-x)); }
__device__ __forceinline__ float gelu_tanh(float x) { const float u = 0.7978845608028654f * (x + 0.044715f * x * x * x); const float t = __expf(2.0f * u); return 0.5f * x * (2.0f - 2.0f / (t + 1.0f)); }
__device__ __forceinline__ float wave_sum(float v) {
#pragma unroll
    for (int o = 1; o < 64; o <<= 1) v += __shfl_xor(v, o);
    return v;
}
__device__ __forceinline__ float wave_max(float v) {
#pragma unroll
    for (int o = 1; o < 64; o <<= 1) v = fmaxf(v, __shfl_xor(v, o));
    return v;
}
__device__ __forceinline__ int pos_index(int row) { return row < MP ? (row & (SEQ - 1)) : SEQ + ((row - MP) & (DECS - 1)); }

#define XB_TMO      128
#define XB_XCNT(j)  (256  + 64 * (j))
#define XB_XSUB(j)  (1280 + 64 * (j))
#define XB_XGEN(j)  (2304 + 64 * (j))
#define XB_TOP      3328
#define XB_TOPGEN   3392
#define XCD_BAR_WORDS 3456
#define XB_SPIN_CAP (1u << 18)

__device__ __forceinline__ unsigned xb_ld(unsigned* p)              { return __hip_atomic_load(p, __ATOMIC_RELAXED, __HIP_MEMORY_SCOPE_AGENT); }
__device__ __forceinline__ unsigned xb_add(unsigned* p, unsigned v) { return __hip_atomic_fetch_add(p, v, __ATOMIC_RELAXED, __HIP_MEMORY_SCOPE_AGENT); }
__device__ __forceinline__ unsigned xb_xcc_id() { return (unsigned)__builtin_amdgcn_s_getreg((3 << 11) | 20) & 0xFu; }
#define XB_SPIN(cond, bar) do { unsigned _sp = 0; while (cond) { __builtin_amdgcn_s_sleep(1); \
    if ((++_sp & 255u) == 0u) { if (xb_ld(&(bar)[XB_TMO])) break; if (_sp > XB_SPIN_CAP) { atomicAdd(&(bar)[XB_TMO], 1u); break; } } } } while (0)

struct XcdBarrier {
    unsigned* bar; unsigned x;
    volatile LAS unsigned* st;
};

__device__ __forceinline__ XcdBarrier xcd_barrier_post(unsigned* bar, volatile LAS unsigned* st) {
    XcdBarrier b; b.bar = bar; b.x = xb_xcc_id(); b.st = st;
    if (threadIdx.x == 0) (void)xb_add(&bar[XB_XCNT(b.x)], 1u);
    return b;
}
__device__ __forceinline__ void xcd_barrier_complete(unsigned* bar, unsigned x, unsigned& nloc, unsigned& nx) {
    const unsigned G = gridDim.x * gridDim.y * gridDim.z;
    unsigned sum, cnt, mine, sp = 0u;
    for (;;) {
        sum = 0u; cnt = 0u; mine = 0u;
#pragma unroll
        for (unsigned j = 0; j < 16; ++j) { const unsigned c = xb_ld(&bar[XB_XCNT(j)]); sum += c; cnt += (c > 0u) ? 1u : 0u; mine = (j == x) ? c : mine; }
        if (sum == G) break;
        __builtin_amdgcn_s_sleep(1);
        if ((++sp & 255u) == 0u) { if (xb_ld(&bar[XB_TMO])) break; if (sp > XB_SPIN_CAP) { atomicAdd(&bar[XB_TMO], 1u); break; } }
    }
    nloc = mine > 0u ? mine : 1u; nx = cnt > 0u ? cnt : 1u;
}

__device__ __forceinline__ void xcd_barrier(const XcdBarrier& b) {
    asm volatile("s_waitcnt vmcnt(0)" ::: "memory");
    __syncthreads();
    if (threadIdx.x == 0) {
        unsigned* bar = b.bar;
        __builtin_amdgcn_s_waitcnt(0);
        unsigned nloc = b.st[0], nx = b.st[1];
        if (nloc == 0u) { xcd_barrier_complete(bar, b.x, nloc, nx); b.st[0] = nloc; b.st[1] = nx; }
        const unsigned old = xb_add(&bar[XB_XSUB(b.x)], 1u);
        const unsigned gen = old / nloc;
        if (old + 1u == (gen + 1u) * nloc) {
            __builtin_amdgcn_fence(__ATOMIC_RELEASE, "agent");
            asm volatile("s_waitcnt vmcnt(0)" ::: "memory");
            const unsigned og = xb_add(&bar[XB_TOP], 1u);
            const unsigned tg = og / nx;
            if (og + 1u == (tg + 1u) * nx) xb_add(&bar[XB_TOPGEN], 1u);
            else XB_SPIN(xb_ld(&bar[XB_TOPGEN]) == tg, bar);
            __builtin_amdgcn_fence(__ATOMIC_ACQUIRE, "agent");
            xb_add(&bar[XB_XGEN(b.x)], 1u);
            asm volatile("s_waitcnt vmcnt(0)" ::: "memory");
        } else {
            XB_SPIN(xb_ld(&bar[XB_XGEN(b.x)]) == gen, bar);
            __builtin_amdgcn_fence(__ATOMIC_ACQUIRE, "agent");
            asm volatile("s_waitcnt vmcnt(0)" ::: "memory");
        }
    }
    __syncthreads();
}

struct Frame {
    LAS unsigned char* lds;
    int tid, lane, wave, G, gw, NGW;
    const float *x_p, *x_s, *cache_k, *cache_v, *cache_ik, *st_a, *st_f; const int* ptab;
    const float *w_in, *ikg, *ikb, *conv_a_w, *w_a_out, *w_attn_out, *w_mix_out, *ln1g, *ln1b, *w_up, *w_gate, *conv_f_w, *conv_f_b, *w_down, *ln2g, *ln2b;
    float* out;
    bf16 *WIN, *WAOUT, *WATTN, *WMIX, *WUG, *WDOWN, *XB, *CB, *CCH, *QB, *KB, *VB, *IQB, *IKB, *SGA, *SGB, *A2, *MA, *OB, *MB, *X1B, *UG, *HC;
    float *IW, *PRE1, *X1, *ZS, *YAS, *SSC; f32x2 *ROPEA, *ROPEB; unsigned long long* MASK;
};

using pg8::Unit;
__device__ __forceinline__ v4u pk8v(f32x4 a, f32x4 b) { v4u w; w.x = pg8::cvt_pk_bf16(a[0], a[1]); w.y = pg8::cvt_pk_bf16(a[2], a[3]); w.z = pg8::cvt_pk_bf16(b[0], b[1]); w.w = pg8::cvt_pk_bf16(b[2], b[3]); return w; }
__device__ __forceinline__ f32x4 sig4(f32x4 a) { f32x4 r; r[0] = sigmoidf_(a[0]); r[1] = sigmoidf_(a[1]); r[2] = sigmoidf_(a[2]); r[3] = sigmoidf_(a[3]); return r; }
__device__ __forceinline__ f32x4 shfl4(f32x4 a, int m) { f32x4 r; r[0] = __shfl_xor(a[0], m); r[1] = __shfl_xor(a[1], m); r[2] = __shfl_xor(a[2], m); r[3] = __shfl_xor(a[3], m); return r; }
__device__ __forceinline__ void bf8_to_f(v4u w, f32x4& a, f32x4& b) { a[0] = bflo(w.x); a[1] = bfhi(w.x); a[2] = bflo(w.y); a[3] = bfhi(w.y); b[0] = bflo(w.z); b[1] = bfhi(w.z); b[2] = bflo(w.w); b[3] = bfhi(w.w); }

struct EpiZ {
    static constexpr bool PERM = true, AFTER_DRAIN = false;
    bf16 *CB, *CCH, *QB, *KB, *VB, *IQB, *SGA, *SGB; float *kout, *vout, *caout; const f32x2 *ropeA, *ropeB;
    __device__ __forceinline__ void operator()(const f32x4 (&acc)[2][2][4][2], const Unit& u, int wr, int wc, int fr, int fq) const {
        const int pn = u.pn, row0 = u.pm * 256 + wr * 64 + fr, lc = wc * 32 + 8 * fq;
        if (pn < 4) {
#pragma unroll
            for (int ai = 0; ai < 2; ++ai)
#pragma unroll
                for (int m = 0; m < 4; ++m) { const size_t row = row0 + ai * 128 + m * 16;
#pragma unroll
                    for (int bj = 0; bj < 2; ++bj) *(v4u*)(CB + row * DCONV + pn * 256 + bj * 128 + lc) = pk8v(acc[ai][bj][m][0], acc[ai][bj][m][1]); }
        } else if (pn < 12) {
            const int c0 = (pn - 4) * 128 + lc;
#pragma unroll
            for (int ai = 0; ai < 2; ++ai)
#pragma unroll
                for (int m = 0; m < 4; ++m) { const int row = row0 + ai * 128 + m * 16; const int t = row & (SEQ - 1);
                    const f32x4 p0 = acc[ai][0][m][0] * acc[ai][1][m][0], p1 = acc[ai][0][m][1] * acc[ai][1][m][1];
                    *(v4u*)(CCH + (size_t)row * DCONV + c0) = pk8v(p0, p1);
                    if (t >= SEQ - 2) { float* o = caout + ((size_t)((row >> 11) * 2 + (t - (SEQ - 2)))) * DCONV + c0; *(f32x4*)o = p0; *(f32x4*)(o + 4) = p1; } }
        } else if (pn < 22) {
            const bool isk = pn >= 20;
            const float sgn = fq < 2 ? -1.f : 1.f;
#pragma unroll
            for (int ai = 0; ai < 2; ++ai)
#pragma unroll
                for (int m = 0; m < 4; ++m) { const int row = row0 + ai * 128 + m * 16; const int t = row & (SEQ - 1);
                    f32x4 cs[4];
                    if (wc == 0) { const f32x4* rp = (const f32x4*)(ropeA + t * 16 + 8 * (fq & 1));
#pragma unroll
                        for (int e = 0; e < 4; ++e) cs[e] = rp[e]; }
#pragma unroll
                    for (int bj = 0; bj < 2; ++bj) { f32x4 v0 = acc[ai][bj][m][0], v1 = acc[ai][bj][m][1];
                        if (wc == 0) { const f32x4 o0 = shfl4(v0, 32), o1 = shfl4(v1, 32);
                            v0[0] = v0[0] * cs[0][0] + sgn * o0[0] * cs[0][1]; v0[1] = v0[1] * cs[0][2] + sgn * o0[1] * cs[0][3];
                            v0[2] = v0[2] * cs[1][0] + sgn * o0[2] * cs[1][1]; v0[3] = v0[3] * cs[1][2] + sgn * o0[3] * cs[1][3];
                            v1[0] = v1[0] * cs[2][0] + sgn * o1[0] * cs[2][1]; v1[1] = v1[1] * cs[2][2] + sgn * o1[1] * cs[2][3];
                            v1[2] = v1[2] * cs[3][0] + sgn * o1[2] * cs[3][1]; v1[3] = v1[3] * cs[3][2] + sgn * o1[3] * cs[3][3]; }
                        if (!isk) *(v4u*)(QB + (size_t)row * DQ + (pn - 12) * 256 + bj * 128 + lc) = pk8v(v0, v1);
                        else { const size_t o = (size_t)row * DKV + (pn - 20) * 256 + bj * 128 + lc; *(v4u*)(KB + o) = pk8v(v0, v1); *(f32x4*)(kout + o) = v0; *(f32x4*)(kout + o + 4) = v1; } } }
        } else if (pn < 24) {
#pragma unroll
            for (int ai = 0; ai < 2; ++ai)
#pragma unroll
                for (int m = 0; m < 4; ++m) { const size_t row = row0 + ai * 128 + m * 16;
#pragma unroll
                    for (int bj = 0; bj < 2; ++bj) { const size_t o = row * DKV + (pn - 22) * 256 + bj * 128 + lc; const f32x4 v0 = acc[ai][bj][m][0], v1 = acc[ai][bj][m][1];
                        *(v4u*)(VB + o) = pk8v(v0, v1); *(f32x4*)(vout + o) = v0; *(f32x4*)(vout + o + 4) = v1; } }
        } else if (pn < 28) {
            const bool rw = (wc & 1) == 0; const float sgn = fq == 0 ? -1.f : 1.f;
#pragma unroll
            for (int ai = 0; ai < 2; ++ai)
#pragma unroll
                for (int m = 0; m < 4; ++m) { const int row = row0 + ai * 128 + m * 16; const int t = row & (SEQ - 1);
                    f32x4 cs[4];
                    if (rw) { const f32x4* rp = (const f32x4*)(ropeB + t * 8);
#pragma unroll
                        for (int e = 0; e < 4; ++e) cs[e] = rp[e]; }
#pragma unroll
                    for (int bj = 0; bj < 2; ++bj) { f32x4 v0 = acc[ai][bj][m][0], v1 = acc[ai][bj][m][1];
                        if (rw) { const f32x4 o0 = shfl4(v0, 16), o1 = shfl4(v1, 16);
                            if (fq < 2) {
                            v0[0] = v0[0] * cs[0][0] + sgn * o0[0] * cs[0][1]; v0[1] = v0[1] * cs[0][2] + sgn * o0[1] * cs[0][3];
                            v0[2] = v0[2] * cs[1][0] + sgn * o0[2] * cs[1][1]; v0[3] = v0[3] * cs[1][2] + sgn * o0[3] * cs[1][3];
                            v1[0] = v1[0] * cs[2][0] + sgn * o1[0] * cs[2][1]; v1[1] = v1[1] * cs[2][2] + sgn * o1[1] * cs[2][3];
                            v1[2] = v1[2] * cs[3][0] + sgn * o1[2] * cs[3][1]; v1[3] = v1[3] * cs[3][2] + sgn * o1[3] * cs[3][3]; } }
                        *(v4u*)(IQB + (size_t)row * DIQ + (pn - 24) * 256 + bj * 128 + lc) = pk8v(v0, v1); } }
        } else {
            bf16* G_ = pn < 36 ? SGA : SGB; const int cb = (pn < 36 ? pn - 28 : pn - 36) * 256;
#pragma unroll
            for (int ai = 0; ai < 2; ++ai)
#pragma unroll
                for (int m = 0; m < 4; ++m) { const size_t row = row0 + ai * 128 + m * 16;
#pragma unroll
                    for (int bj = 0; bj < 2; ++bj) *(v4u*)(G_ + row * DM + cb + bj * 128 + lc) = pk8v(sig4(acc[ai][bj][m][0]), sig4(acc[ai][bj][m][1])); }
        }
    }
};
template <int MODE> struct EpiMerge {
    static constexpr bool PERM = true, AFTER_DRAIN = false;
    const bf16* SG; const bf16* MAin; bf16* O;
    __device__ __forceinline__ void operator()(const f32x4 (&acc)[2][2][4][2], const Unit& u, int wr, int wc, int fr, int fq) const {
        const int row0 = u.pm * 256 + wr * 64 + fr, col0 = u.pn * 256 + wc * 32 + 8 * fq;
#pragma unroll
        for (int ai = 0; ai < 2; ++ai)
#pragma unroll
            for (int m = 0; m < 4; ++m) { const size_t row = row0 + ai * 128 + m * 16;
#pragma unroll
                for (int bj = 0; bj < 2; ++bj) { const size_t o = row * DM + col0 + bj * 128; f32x4 g0, g1; bf8_to_f(*(const v4u*)(SG + o), g0, g1);
                    f32x4 r0 = g0 * acc[ai][bj][m][0], r1 = g1 * acc[ai][bj][m][1];
                    if (MODE == 1) { f32x4 a0, a1; bf8_to_f(*(const v4u*)(MAin + o), a0, a1); r0 += a0; r1 += a1; }
                    *(v4u*)(O + o) = pk8v(r0, r1); } }
    }
};
struct EpiResid {
    static constexpr bool PERM = false, AFTER_DRAIN = false;
    const float* R; float* O;
    __device__ __forceinline__ void operator()(const f32x4 (&acc)[2][2][4][2], const Unit& u, int wr, int wc, int fr, int fq) const {
        const int row0 = u.pm * 256 + wr * 64 + fr, col0 = u.pn * 256 + wc * 32 + 4 * fq;
#pragma unroll
        for (int ai = 0; ai < 2; ++ai)
#pragma unroll
            for (int m = 0; m < 4; ++m) { const size_t ro = (size_t)(row0 + ai * 128 + m * 16) * DM + col0;
#pragma unroll
                for (int bj = 0; bj < 2; ++bj)
#pragma unroll
                    for (int n = 0; n < 2; ++n) { const size_t o = ro + bj * 128 + n * 16; *(f32x4*)(O + o) = *(const f32x4*)(R + o) * ALPHA + acc[ai][bj][m][n]; } }
    }
};
struct EpiUG {
    static constexpr bool PERM = true, AFTER_DRAIN = false;
    bf16* UG; float* cfout;
    __device__ __forceinline__ void operator()(const f32x4 (&acc)[2][2][4][2], const Unit& u, int wr, int wc, int fr, int fq) const {
        const int row0 = u.pm * 256 + wr * 64 + fr, lc = wc * 32 + 8 * fq;
#pragma unroll
        for (int ai = 0; ai < 2; ++ai)
#pragma unroll
            for (int m = 0; m < 4; ++m) { const int row = row0 + ai * 128 + m * 16; const int t = row & (SEQ - 1);
#pragma unroll
                for (int bj = 0; bj < 2; ++bj) *(v4u*)(UG + (size_t)row * NUG + u.pn * 256 + bj * 128 + lc) = pk8v(acc[ai][bj][m][0], acc[ai][bj][m][1]);
                if (t >= SEQ - 2) { float* o = cfout + ((size_t)((row >> 11) * 2 + (t - (SEQ - 2)))) * DFF + u.pn * 128 + lc; *(f32x4*)o = acc[ai][0][m][0]; *(f32x4*)(o + 4) = acc[ai][0][m][1]; } }
    }
};

template <int NT, class E>
__device__ __forceinline__ void skinny_gemm(const Frame& F, const bf16* A, const bf16* Bt, int K, int ntn, const E& epi) {
    const int fr = F.lane & 15, fq = F.lane >> 4; const int nitems = (ntn + NT - 1) / NT;
    const bf16* ap = A + (size_t)(16 * F.wave + fr) * K + 16 * fq;
    for (int it = blockIdx.x; it < nitems; it += F.G) {
        f32x4 acc[NT]; const bf16* bp[NT];
#pragma unroll
        for (int j = 0; j < NT; ++j) { acc[j] = (f32x4){0.f, 0.f, 0.f, 0.f}; int tl = it * NT + j; tl = tl < ntn ? tl : ntn - 1; bp[j] = Bt + (size_t)(16 * tl + fr) * K + 16 * fq; }
#pragma unroll 2
        for (int kc = 0; kc < K; kc += 64) {
            const bf16x8 a0 = *(const bf16x8*)(ap + kc), a1 = *(const bf16x8*)(ap + kc + 8);
#pragma unroll
            for (int j = 0; j < NT; ++j) { const bf16x8 b0 = *(const bf16x8*)(bp[j] + kc), b1 = *(const bf16x8*)(bp[j] + kc + 8);
                acc[j] = __builtin_amdgcn_mfma_f32_16x16x32_bf16(b0, a0, acc[j], 0, 0, 0); acc[j] = __builtin_amdgcn_mfma_f32_16x16x32_bf16(b1, a1, acc[j], 0, 0, 0); }
        }
#pragma unroll
        for (int j = 0; j < NT; ++j) { const int tl = it * NT + j; if (tl < ntn) epi(16 * F.wave + fr, 16 * tl + 4 * fq, acc[j]); }
    }
}

template <int MAP> __device__ __forceinline__ int phys_row(int l) {
    if (MAP == 0) return l;
    if (MAP == 1) {
        if (l < 1024) return l;
        if (l < 2048) { const int c = l - 1024; return 1024 + ((c >> 7) << 8) + (c & 127); }
        if (l < 3072) { const int c = l - 2048; return 1024 + ((c >> 7) << 8) + 128 + (c & 127); }
        if (l < 7168) return l;
        if (l < 7248) return NZ + (l - 7168);
        return l - 80; }
    if (MAP == 2) return ((l >> 7) << 8) + (l & 127);
    return ((l >> 7) << 8) + 128 + (l & 127);
}
template <int MAP> __device__ __forceinline__ void transpose_item(const float* W, int K, int N, bf16* WT, LAS float* scr, int item, int lane) {
    const int nblk = (N + 31) / 32, kb = item / nblk, nb = item % nblk, k0 = 64 * kb, n0 = 32 * nb;
    const int nn = n0 + (lane & 31);
#pragma unroll 8
    for (int i = 0; i < 32; ++i) { const int kk = 2 * i + (lane >> 5); scr[kk * 33 + (lane & 31)] = nn < N ? W[(size_t)(k0 + kk) * N + nn] : 0.f; }
    LDS_WAIT();
    const int c = lane & 7;
#pragma unroll
    for (int j = 0; j < 4; ++j) { const int n = (lane >> 3) + 8 * j; const LAS float* s = scr + (8 * c) * 33 + n;
        v4u o; o.x = pk2(s[0 * 33], s[1 * 33]); o.y = pk2(s[2 * 33], s[3 * 33]); o.z = pk2(s[4 * 33], s[5 * 33]); o.w = pk2(s[6 * 33], s[7 * 33]);
        if (n0 + n < N) *(v4u*)(WT + (size_t)phys_row<MAP>(n0 + n) * K + k0 + 8 * c) = o; }
    LDS_WAIT();
}
__device__ __forceinline__ void sincos_d(double a, float& c, float& s) {
    const double k = __builtin_rint(a * 0.63661977236758134308); const double y = (a - k * 1.57079632679489655800) - k * 6.12323399573676603587e-17; const double y2 = y * y;
    double sy = y * (1.0 + y2 * (-1.0 / 6 + y2 * (1.0 / 120 + y2 * (-1.0 / 5040 + y2 * (1.0 / 362880 + y2 * (-1.0 / 39916800 + y2 * (1.0 / 6227020800.0)))))));
    double cy = 1.0 + y2 * (-0.5 + y2 * (1.0 / 24 + y2 * (-1.0 / 720 + y2 * (1.0 / 40320 + y2 * (-1.0 / 3628800 + y2 * (1.0 / 479001600.0 + y2 * (-1.0 / 87178291200.0)))))));
    const int q = ((int)(long long)k) & 3;
    const double ss = (q & 1) ? cy : sy, cc = (q & 1) ? sy : cy;
    s = (float)((q & 2) ? -ss : ss); c = (float)(((q + 1) & 2) ? -cc : cc);
}
__device__ __forceinline__ void p0_prologue(Frame& F) {
    LAS float* scr = (LAS float*)(F.lds + F.wave * 16384);
    constexpr int I_IN = 32 * 355, I_AO = 16 * 64, I_AT = 32 * 64, I_MX = 32 * 64, I_UP = 32 * 176, I_GT = 32 * 176, I_DN = 88 * 64;
    constexpr int NITEMS = I_IN + I_AO + I_AT + I_MX + I_UP + I_GT + I_DN;
    for (int it = F.gw; it < NITEMS; it += F.NGW) {
        int r = it;
        if (r < I_IN) { transpose_item<1>(F.w_in, DM, DIN, F.WIN, scr, r, F.lane); continue; } r -= I_IN;
        if (r < I_AO) { transpose_item<0>(F.w_a_out, DCONV, DM, F.WAOUT, scr, r, F.lane); continue; } r -= I_AO;
        if (r < I_AT) { transpose_item<0>(F.w_attn_out, DQ, DM, F.WATTN, scr, r, F.lane); continue; } r -= I_AT;
        if (r < I_MX) { transpose_item<0>(F.w_mix_out, DM, DM, F.WMIX, scr, r, F.lane); continue; } r -= I_MX;
        if (r < I_UP) { transpose_item<2>(F.w_up, DM, DFF, F.WUG, scr, r, F.lane); continue; } r -= I_UP;
        if (r < I_GT) { transpose_item<3>(F.w_gate, DM, DFF, F.WUG, scr, r, F.lane); continue; } r -= I_GT;
        transpose_item<0>(F.w_down, DFF, DM, F.WDOWN, scr, r, F.lane);
    }
    for (int m = F.gw; m < MALL; m += F.NGW) {
        const f32x4* xr = (const f32x4*)(m < MP ? F.x_p + (size_t)m * DM : F.x_s + (size_t)(m - MP) * DM) + 2 * F.lane;
        v4u* o = (v4u*)(F.XB + (size_t)m * DM) + F.lane;
#pragma unroll
        for (int j = 0; j < 4; ++j) { const f32x4 a = xr[128 * j], b = xr[128 * j + 1]; o[64 * j] = pk8v(a, b); }
    }
    const double fa[16] = {1.0, 0.44036660267178046, 0.19392274474868576, 0.08539710028576561, 0.03760603093086393, 0.016560440080994446, 0.007292664737217109, 0.003211445994752591,
                           0.001414213562373095, 0.000622772421914596, 0.0002742481756762073, 0.00012076973741146504, 5.318295896944988e-05, 2.341999896140934e-05, 1.031338537721246e-05, 4.5416704806078695e-06};
    for (int e = blockIdx.x * 512 + F.tid; e < (SEQ + DECS) * 24; e += F.G * 512) {
        const int pi = e / 24, j = e % 24; const double pos = pi < SEQ ? (double)pi : (double)(PAST + pi - SEQ);
        double fr_ = 1.0;
#pragma unroll
        for (int i = 0; i < 16; ++i) { const int want = j < 16 ? j : 2 * (j - 16); if (i == want) fr_ = fa[i]; }
        float c, s; sincos_d(pos * fr_, c, s);
        if (j < 16) F.ROPEA[pi * 16 + j] = (f32x2){c, s}; else F.ROPEB[pi * 8 + (j - 16)] = (f32x2){c, s};
    }
}

__device__ __forceinline__ void ikiw_phase(Frame& F) {
    LAS float* T = (LAS float*)F.lds;
    const int fr = F.lane & 15, fq = F.lane >> 4, mt = F.wave & 3, ng = F.wave >> 2;
    for (int rb = blockIdx.x; rb < MALL / 64; rb += F.G) {
        f32x4 acc[3]; const bf16* bp[3];
        const bf16* ap = F.XB + (size_t)(rb * 64 + mt * 16 + fr) * DM + 16 * fq;
#pragma unroll
        for (int j = 0; j < 3; ++j) { acc[j] = (f32x4){0.f, 0.f, 0.f, 0.f}; int tl = ng * 3 + j; tl = tl < 5 ? tl : 4; bp[j] = F.WIN + (size_t)(NZ + 16 * tl + fr) * DM + 16 * fq; }
#pragma unroll 2
        for (int kc = 0; kc < DM; kc += 64) {
            const bf16x8 a0 = *(const bf16x8*)(ap + kc), a1 = *(const bf16x8*)(ap + kc + 8);
#pragma unroll
            for (int j = 0; j < 3; ++j) { const bf16x8 b0 = *(const bf16x8*)(bp[j] + kc), b1 = *(const bf16x8*)(bp[j] + kc + 8);
                acc[j] = __builtin_amdgcn_mfma_f32_16x16x32_bf16(b0, a0, acc[j], 0, 0, 0); acc[j] = __builtin_amdgcn_mfma_f32_16x16x32_bf16(b1, a1, acc[j], 0, 0, 0); }
        }
#pragma unroll
        for (int j = 0; j < 3; ++j) { const int tl = ng * 3 + j; if (tl < 5) {
#pragma unroll
            for (int i = 0; i < 4; ++i) T[(mt * 16 + fr) * 81 + 16 * tl + 4 * fq + i] = acc[j][i]; } }
        __syncthreads();
        {   const int row = F.tid >> 3, g8 = F.tid & 7, grow = rb * 64 + row;
            float v[8]; float s = 0.f;
#pragma unroll
            for (int e = 0; e < 8; ++e) { v[e] = T[row * 81 + 8 * g8 + e]; s += v[e]; }
            s += __shfl_xor(s, 1); s += __shfl_xor(s, 2); s += __shfl_xor(s, 4);
            const float mean = s * (1.f / 64.f); float q = 0.f;
#pragma unroll
            for (int e = 0; e < 8; ++e) { v[e] -= mean; q += v[e] * v[e]; }
            q += __shfl_xor(q, 1); q += __shfl_xor(q, 2); q += __shfl_xor(q, 4);
            const float rstd = 1.0f / sqrtf(q * (1.f / 64.f) + LN_EPS);
            float y[8], o[8];
#pragma unroll
            for (int e = 0; e < 8; ++e) y[e] = v[e] * rstd * F.ikg[8 * g8 + e] + F.ikb[8 * g8 + e];
#pragma unroll
            for (int e = 0; e < 8; ++e) o[e] = __shfl_xor(y[e], 1);
            const f32x2* rp = F.ROPEB + pos_index(grow) * 8;
            if (g8 < 2) { const float sgn = g8 == 0 ? -1.f : 1.f;
#pragma unroll
                for (int e = 0; e < 8; ++e) { const f32x2 cs = rp[e]; y[e] = y[e] * cs.x + sgn * o[e] * cs.y; } }
            *(v4u*)(F.IKB + (size_t)grow * IDD + 8 * g8) = pack8(y);
            float* op = grow < MP ? F.out + O_IKP + (size_t)grow * IDD + 8 * g8 : F.out + O_IKS + (size_t)(grow - MP) * IDD + 8 * g8;
            *(f32x4*)op = (f32x4){y[0], y[1], y[2], y[3]}; *(f32x4*)(op + 4) = (f32x4){y[4], y[5], y[6], y[7]};
            if (g8 < 2) {
#pragma unroll
                for (int e = 0; e < 8; ++e) F.IW[(size_t)grow * NIH + 8 * g8 + e] = T[row * 81 + 64 + 8 * g8 + e] * (0.25f * 0.125f); }
        }
        __syncthreads();
    }
}
struct EpiRawF32 { float* O; int ld; __device__ __forceinline__ void operator()(int r, int c, f32x4 v) const { *(f32x4*)(O + (size_t)r * ld + c) = v; } };

__device__ __forceinline__ void p2_pointwise(Frame& F) {
    const int gt = blockIdx.x * 512 + F.tid, NT_ = F.G * 512;
    for (int it = gt; it < MP * 128; it += NT_) {
        const int row = it >> 7, c0 = (it & 127) * 8, t = row & (SEQ - 1);
        float cb[8], u0[8], u1[8], u2[8], r[8];
        unpack8(*(const v4u*)(F.CB + (size_t)row * DCONV + c0), cb);
        unpack8(*(const v4u*)(F.CCH + (size_t)row * DCONV + c0), u2);
        if (t >= 1) unpack8(*(const v4u*)(F.CCH + (size_t)(row - 1) * DCONV + c0), u1); else zero8(u1);
        if (t >= 2) unpack8(*(const v4u*)(F.CCH + (size_t)(row - 2) * DCONV + c0), u0); else zero8(u0);
#pragma unroll
        for (int e = 0; e < 8; ++e) r[e] = cb[e] * (F.conv_a_w[c0 + e] * u0[e] + F.conv_a_w[DCONV + c0 + e] * u1[e] + F.conv_a_w[2 * DCONV + c0 + e] * u2[e]);
        *(v4u*)(F.A2 + (size_t)row * DCONV + c0) = pack8(r);
    }
    const float* Z = F.ZS;
    for (int it = gt; it < MS * DCONV; it += NT_) {
        const int r = it >> 10, c = it & 1023, b = r >> 2, t = r & 3; const int pcc = 1024 + ((c >> 7) << 8) + (c & 127), pch = pcc + 128;
        float ext[3];
#pragma unroll
        for (int j = 0; j < 3; ++j) { const int i = t + j; ext[j] = i < 2 ? F.st_a[(size_t)(b * 2 + i) * DCONV + c] : Z[(size_t)(4 * b + i - 2) * NZ + pcc] * Z[(size_t)(4 * b + i - 2) * NZ + pch]; }
        const float y = F.conv_a_w[c] * ext[0] + F.conv_a_w[DCONV + c] * ext[1] + F.conv_a_w[2 * DCONV + c] * ext[2];
        F.A2[(size_t)(MP + r) * DCONV + c] = (bf16)f2bf(Z[(size_t)r * NZ + c] * y);
        if (t >= 2) F.out[O_CAS + (size_t)(b * 2 + (t - 2)) * DCONV + c] = ext[2];
    }
    for (int it = gt; it < MS * DQ; it += NT_) {
        const int r = it >> 11, col = it & 2047, d = col & 127, t = r & 3, p = 3072 + col; float v = Z[(size_t)r * NZ + p];
        if (d < 32) { const f32x2 cs = F.ROPEA[(SEQ + t) * 16 + (d & 15)]; v = d < 16 ? v * cs.x - Z[(size_t)r * NZ + p + 16] * cs.y : v * cs.x + Z[(size_t)r * NZ + p - 16] * cs.y; }
        F.QB[(size_t)(MP + r) * DQ + col] = (bf16)f2bf(v);
    }
    for (int it = gt; it < MS * DKV; it += NT_) {
        const int r = it >> 9, col = it & 511, d = col & 127, t = r & 3, p = 5120 + col; float v = Z[(size_t)r * NZ + p];
        if (d < 32) { const f32x2 cs = F.ROPEA[(SEQ + t) * 16 + (d & 15)]; v = d < 16 ? v * cs.x - Z[(size_t)r * NZ + p + 16] * cs.y : v * cs.x + Z[(size_t)r * NZ + p - 16] * cs.y; }
        F.KB[(size_t)(MP + r) * DKV + col] = (bf16)f2bf(v); F.out[O_KS + (size_t)r * DKV + col] = v;
        const float vv = Z[(size_t)r * NZ + 5632 + col];
        F.VB[(size_t)(MP + r) * DKV + col] = (bf16)f2bf(vv); F.out[O_VS + (size_t)r * DKV + col] = vv;
    }
    for (int it = gt; it < MS * DIQ; it += NT_) {
        const int r = it >> 10, col = it & 1023, d = col & 63, t = r & 3, p = 6144 + col; float v = Z[(size_t)r * NZ + p];
        if (d < 16) { const f32x2 cs = F.ROPEB[(SEQ + t) * 8 + (d & 7)]; v = d < 8 ? v * cs.x - Z[(size_t)r * NZ + p + 8] * cs.y : v * cs.x + Z[(size_t)r * NZ + p - 8] * cs.y; }
        F.IQB[(size_t)(MP + r) * DIQ + col] = (bf16)f2bf(v);
    }
    for (int it = gt; it < MS * DM; it += NT_) {
        const int r = it >> 11, col = it & 2047;
        F.SGA[(size_t)(MP + r) * DM + col] = (bf16)f2bf(sigmoidf_(Z[(size_t)r * NZ + 7168 + col]));
        F.SGB[(size_t)(MP + r) * DM + col] = (bf16)f2bf(sigmoidf_(Z[(size_t)r * NZ + 9216 + col]));
    }
}

__device__ __forceinline__ unsigned sortable(float f) { const unsigned b = __builtin_bit_cast(unsigned, f); return b ^ ((unsigned)((int)b >> 31) | 0x80000000u); }
template <int NREG> __device__ __forceinline__ unsigned kth_largest(const unsigned (&x)[NREG], int K) {
    unsigned tau = 0u;
    for (int bit = 31; bit >= 0; --bit) {
        const unsigned cand = tau | (1u << bit); int c = 0;
#pragma unroll
        for (int i = 0; i < NREG; ++i) c += __popcll(__ballot(x[i] >= cand));
        if (c >= K) tau = cand;
    }
    return tau;
}
template <int NREG> __device__ __forceinline__ int select_topk(const unsigned (&x)[NREG], int K, int lane, LAS int* lst) {
    const unsigned tau = kth_largest<NREG>(x, K);
    int cgt = 0;
#pragma unroll
    for (int i = 0; i < NREG; ++i) cgt += __popcll(__ballot(x[i] > tau));
    const int need = K - cgt; int base = 0, eqt = 0; const unsigned long long lt = (1ull << lane) - 1ull;
#pragma unroll
    for (int i = 0; i < NREG; ++i) {
        const bool gt = x[i] > tau, eq = (x[i] == tau) && (tau != 0u);
        const unsigned long long meq = __ballot(eq);
        const bool sel = gt || (eq && (eqt + __popcll(meq & lt)) < need);
        const unsigned long long ms = __ballot(sel);
        if (sel) lst[base + __popcll(ms & lt)] = 64 * i + lane;
        base += __popcll(ms); eqt += __popcll(meq);
    }
    return base;
}

__device__ __forceinline__ void naive_prompt_query(Frame& F, int q, LAS float* wl) {
    const int b = q >> 11, t = q & (SEQ - 1), lane = F.lane;
    LAS float* iqf = wl;
    LAS float* sc = wl + 1024;
    LAS int* lst = (LAS int*)(wl + 3072);
    LAS float* wv = wl + 3328;
    {   const v4u* ip = (const v4u*)(F.IQB + (size_t)q * DIQ) + 2 * lane;
#pragma unroll
        for (int k = 0; k < 2; ++k) { float f[8]; unpack8(ip[k], f);
#pragma unroll
            for (int e = 0; e < 8; ++e) iqf[lane * 16 + k * 8 + e] = f[e]; }
        if (lane < 16) wv[lane] = F.IW[(size_t)q * NIH + lane];
    }
    LDS_WAIT();
    const int nI = (t >> 6) + 1;
    for (int i = 0; i < nI; ++i) {
        const int s = 64 * i + lane;
        const v4u* kp = (const v4u*)(F.IKB + (size_t)(b * SEQ + s) * IDD);
        float kf[64];
#pragma unroll
        for (int k = 0; k < 8; ++k) { float f[8]; unpack8(kp[k], f);
#pragma unroll
            for (int e = 0; e < 8; ++e) kf[8 * k + e] = f[e]; }
        float tot = 0.f;
#pragma unroll 1
        for (int h = 0; h < NIH; ++h) { float d = 0.f;
#pragma unroll
            for (int dd = 0; dd < 64; ++dd) d += iqf[h * 64 + dd] * kf[dd];
            tot += wv[h] * fmaxf(d, 0.f); }
        sc[s] = tot;
    }
    LDS_WAIT();
    unsigned x[32];
#pragma unroll
    for (int i = 0; i < 32; ++i) { const int s = 64 * i + lane; x[i] = s <= t ? sortable(sc[s]) : 0u; }
    LDS_WAIT();
    const int nsel = select_topk<32>(x, TOPK, lane, lst);
    {   const v4u* qp = (const v4u*)(F.QB + (size_t)q * DQ) + 4 * lane;
#pragma unroll
        for (int k = 0; k < 4; ++k) { float f[8]; unpack8(qp[k], f);
#pragma unroll
            for (int e = 0; e < 8; ++e) sc[lane * 32 + k * 8 + e] = f[e]; }
    }
    LDS_WAIT();
    LAS float* pl = iqf;
#pragma unroll 1
    for (int kvh = 0; kvh < NKV; ++kvh) {
        float lg[4][4];
#pragma unroll
        for (int jj = 0; jj < 4; ++jj) {
            const int j = lane + 64 * jj; const bool valid = j < nsel; const int idx = valid ? lst[j] : 0;
            const v4u* kp = (const v4u*)(F.KB + (size_t)(b * SEQ + idx) * DKV + kvh * HD);
            float a4[4] = {0.f, 0.f, 0.f, 0.f};
#pragma unroll 1
            for (int hf = 0; hf < 2; ++hf) {
                float kf[64];
#pragma unroll
                for (int k = 0; k < 8; ++k) { float f[8]; unpack8(kp[hf * 8 + k], f);
#pragma unroll
                    for (int e = 0; e < 8; ++e) kf[8 * k + e] = f[e]; }
#pragma unroll
                for (int g = 0; g < 4; ++g) { float d = 0.f;
#pragma unroll
                    for (int dd = 0; dd < 64; ++dd) d += sc[(4 * kvh + g) * HD + hf * 64 + dd] * kf[dd];
                    a4[g] += d; }
            }
#pragma unroll
            for (int g = 0; g < 4; ++g) lg[g][jj] = valid ? a4[g] * 0.08838834764831845f : -__builtin_inff();
        }
#pragma unroll
        for (int g = 0; g < 4; ++g) {
            const float m = wave_max(fmaxf(fmaxf(lg[g][0], lg[g][1]), fmaxf(lg[g][2], lg[g][3])));
            float e4[4], s = 0.f;
#pragma unroll
            for (int jj = 0; jj < 4; ++jj) { e4[jj] = __expf(lg[g][jj] - m); s += e4[jj]; }
            const float inv = 1.0f / wave_sum(s);
#pragma unroll
            for (int jj = 0; jj < 4; ++jj) pl[g * 256 + lane + 64 * jj] = e4[jj] * inv;
        }
        LDS_WAIT();
        float o[4][2];
#pragma unroll
        for (int g = 0; g < 4; ++g) { o[g][0] = 0.f; o[g][1] = 0.f; }
        for (int j = 0; j < nsel; ++j) {
            const int idx = lst[j];
            const unsigned w = *((const unsigned*)(F.VB + (size_t)(b * SEQ + idx) * DKV + kvh * HD) + lane);
            const float v0 = bflo(w), v1 = bfhi(w);
#pragma unroll
            for (int g = 0; g < 4; ++g) { const float p = pl[g * 256 + j]; o[g][0] += p * v0; o[g][1] += p * v1; }
        }
#pragma unroll
        for (int g = 0; g < 4; ++g) *((unsigned*)(F.OB + (size_t)q * DQ + (4 * kvh + g) * HD) + lane) = pk2(o[g][0], o[g][1]);
        LDS_WAIT();
    }
}
__device__ __forceinline__ void naive_prompt_attention(Frame& F) {
    LAS float* wl = (LAS float*)(F.lds + F.wave * 14336);
    for (int q = F.gw; q < MP; q += F.NGW) naive_prompt_query(F, q, wl);
}

__device__ __forceinline__ void sample_scores(Frame& F) {
    LAS float* iqf = (LAS float*)F.lds;
    LAS float* wv = iqf + 4096;
    for (int it = blockIdx.x; it < DECB * 8; it += F.G) {
        const int b = it >> 3, c = it & 7;
        __syncthreads();
        {   const v4u* ip = (const v4u*)(F.IQB + (size_t)(MP + 4 * b) * DIQ) + F.tid;
            float f[8]; unpack8(*ip, f);
#pragma unroll
            for (int e = 0; e < 8; ++e) iqf[F.tid * 8 + e] = f[e];
            if (F.tid < 64) wv[F.tid] = F.IW[(size_t)(MP + 4 * b) * NIH + F.tid];
        }
        __syncthreads();
        for (int rep = 0; rep < 3; ++rep) {
            int s; const float* kp32 = nullptr; const bf16* kp16 = nullptr;
            if (rep < 2) { s = c * 1024 + rep * 512 + F.tid; const int pg = F.ptab[b * NPAGES + (s >> 7)]; kp32 = F.cache_ik + ((size_t)pg * PAGE + (s & 127)) * IDD; }
            else { if (c != 7 || F.tid >= DECS) break; s = PAST + F.tid; kp16 = F.IKB + (size_t)(MP + 4 * b + F.tid) * IDD; }
            float kf[64];
            if (rep < 2) {
#pragma unroll
                for (int k = 0; k < 16; ++k) { const f32x4 v = ((const f32x4*)kp32)[k]; kf[4 * k] = v[0]; kf[4 * k + 1] = v[1]; kf[4 * k + 2] = v[2]; kf[4 * k + 3] = v[3]; }
            } else {
#pragma unroll
                for (int k = 0; k < 8; ++k) { float f[8]; unpack8(((const v4u*)kp16)[k], f);
#pragma unroll
                    for (int e = 0; e < 8; ++e) kf[8 * k + e] = f[e]; }
            }
#pragma unroll 1
            for (int t = 0; t < DECS; ++t) { float tot = 0.f;
#pragma unroll 1
                for (int h = 0; h < NIH; ++h) { float d = 0.f;
#pragma unroll
                    for (int dd = 0; dd < 64; ++dd) d += iqf[(t * 16 + h) * 64 + dd] * kf[dd];
                    tot += wv[t * 16 + h] * fmaxf(d, 0.f); }
                F.SSC[(size_t)(4 * b + t) * SSC_PITCH + s] = tot; }
        }
    }
}
__device__ __forceinline__ void sample_attend(Frame& F) {
    LAS int* lst = (LAS int*)F.lds;
    LAS float* qf = (LAS float*)(F.lds + 1024);
    LAS float* pl = (LAS float*)(F.lds + 1024 + 8192) + F.wave * 256;
    const int lane = F.lane;
    for (int r = blockIdx.x; r < MS; r += F.G) {
        const int b = r >> 2, t = r & 3;
        __syncthreads();
        if (F.wave == 0) {
            unsigned x[129]; const float* sp = F.SSC + (size_t)r * SSC_PITCH;
#pragma unroll
            for (int i = 0; i < 129; ++i) { const int s = 64 * i + lane; x[i] = s <= PAST + t ? sortable(sp[s]) : 0u; }
            (void)select_topk<129>(x, TOPK, lane, lst);
        }
        {   const v4u* qp = (const v4u*)(F.QB + (size_t)(MP + r) * DQ); if (F.tid < 256) { float f[8]; unpack8(qp[F.tid], f);
#pragma unroll
                for (int e = 0; e < 8; ++e) qf[F.tid * 8 + e] = f[e]; } }
        __syncthreads();
#pragma unroll 1
        for (int hh = 0; hh < 2; ++hh) {
            const int h = 2 * F.wave + hh, kvh = h >> 2;
            float lg[4];
#pragma unroll 1
            for (int jj = 0; jj < 4; ++jj) {
                const int idx = lst[lane + 64 * jj]; float d = 0.f;
                if (idx < PAST) { const int pg = F.ptab[b * NPAGES + (idx >> 7)]; const f32x4* kp = (const f32x4*)(F.cache_k + (((size_t)pg * PAGE + (idx & 127)) * NKV + kvh) * HD);
#pragma unroll 8
                    for (int k = 0; k < 32; ++k) { const f32x4 v = kp[k]; d += qf[h * HD + 4 * k] * v[0] + qf[h * HD + 4 * k + 1] * v[1] + qf[h * HD + 4 * k + 2] * v[2] + qf[h * HD + 4 * k + 3] * v[3]; } }
                else { const v4u* kp = (const v4u*)(F.KB + (size_t)(MP + 4 * b + (idx - PAST)) * DKV + kvh * HD);
#pragma unroll 4
                    for (int k = 0; k < 16; ++k) { float f[8]; unpack8(kp[k], f);
#pragma unroll
                        for (int e = 0; e < 8; ++e) d += qf[h * HD + 8 * k + e] * f[e]; } }
                lg[jj] = d * 0.08838834764831845f;
            }
            const float m = wave_max(fmaxf(fmaxf(lg[0], lg[1]), fmaxf(lg[2], lg[3])));
            float e4[4], s = 0.f;
#pragma unroll
            for (int jj = 0; jj < 4; ++jj) { e4[jj] = __expf(lg[jj] - m); s += e4[jj]; }
            const float inv = 1.0f / wave_sum(s);
#pragma unroll
            for (int jj = 0; jj < 4; ++jj) pl[lane + 64 * jj] = e4[jj] * inv;
            LDS_WAIT();
            float o0 = 0.f, o1 = 0.f;
            for (int j = 0; j < TOPK; ++j) {
                const int idx = lst[j]; const float p = pl[j]; float v0, v1;
                if (idx < PAST) { const int pg = F.ptab[b * NPAGES + (idx >> 7)]; const f32x2 v = *((const f32x2*)(F.cache_v + (((size_t)pg * PAGE + (idx & 127)) * NKV + kvh) * HD) + lane); v0 = v.x; v1 = v.y; }
                else { const unsigned w = *((const unsigned*)(F.VB + (size_t)(MP + 4 * b + (idx - PAST)) * DKV + kvh * HD) + lane); v0 = bflo(w); v1 = bfhi(w); }
                o0 += p * v0; o1 += p * v1;
            }
            *((unsigned*)(F.OB + (size_t)(MP + r) * DQ + h * HD) + lane) = pk2(o0, o1);
            LDS_WAIT();
        }
    }
}

template <bool WB> __device__ __forceinline__ void ln_rows(Frame& F, const float* in, float* outf, bf16* outb, const float* g, const float* bta) {
    for (int m = F.gw; m < MALL; m += F.NGW) {
        const f32x4* xr = (const f32x4*)(in + (size_t)m * DM) + 2 * F.lane;
        f32x4 v[8]; float s = 0.f;
#pragma unroll
        for (int j = 0; j < 4; ++j) { v[2 * j] = xr[128 * j]; v[2 * j + 1] = xr[128 * j + 1]; }
#pragma unroll
        for (int j = 0; j < 8; ++j) s += (v[j][0] + v[j][1]) + (v[j][2] + v[j][3]);
        const float mean = wave_sum(s) * (1.f / DM); float s2 = 0.f;
#pragma unroll
        for (int j = 0; j < 8; ++j) { v[j] = v[j] - mean; s2 += (v[j][0] * v[j][0] + v[j][1] * v[j][1]) + (v[j][2] * v[j][2] + v[j][3] * v[j][3]); }
        const float rstd = 1.0f / sqrtf(wave_sum(s2) * (1.f / DM) + LN_EPS);
        f32x4* of = (f32x4*)(outf + (size_t)m * DM) + 2 * F.lane; const f32x4* gp = (const f32x4*)g + 2 * F.lane; const f32x4* bp = (const f32x4*)bta + 2 * F.lane;
#pragma unroll
        for (int j = 0; j < 4; ++j) { const f32x4 y0 = v[2 * j] * rstd * gp[128 * j] + bp[128 * j], y1 = v[2 * j + 1] * rstd * gp[128 * j + 1] + bp[128 * j + 1];
            of[128 * j] = y0; of[128 * j + 1] = y1;
            if (WB) ((v4u*)(outb + (size_t)m * DM) + F.lane)[64 * j] = pk8v(y0, y1); }
    }
}
__device__ __forceinline__ void hc_pass(Frame& F) {
    const int gt = blockIdx.x * 512 + F.tid, NT_ = F.G * 512;
    for (int it = gt; it < MALL * (DFF / 8); it += NT_) {
        const int row = it / (DFF / 8), f0 = (it % (DFF / 8)) * 8; const int pc = ((f0 >> 7) << 8) + (f0 & 127);
        float u2[8], u1[8], u0[8], gg[8], r[8];
        unpack8(*(const v4u*)(F.UG + (size_t)row * NUG + pc), u2);
        unpack8(*(const v4u*)(F.UG + (size_t)row * NUG + pc + 128), gg);
        if (row < MP) { const int t = row & (SEQ - 1);
            if (t >= 1) unpack8(*(const v4u*)(F.UG + (size_t)(row - 1) * NUG + pc), u1); else {
#pragma unroll
                for (int e = 0; e < 8; ++e) u1[e] = 0.f; }
            if (t >= 2) unpack8(*(const v4u*)(F.UG + (size_t)(row - 2) * NUG + pc), u0); else {
#pragma unroll
                for (int e = 0; e < 8; ++e) u0[e] = 0.f; }
        } else { const int r_ = row - MP, b = r_ >> 2, t = r_ & 3;
            if (t >= 1) unpack8(*(const v4u*)(F.UG + (size_t)(row - 1) * NUG + pc), u1); else {
#pragma unroll
                for (int e = 0; e < 8; ++e) u1[e] = F.st_f[(size_t)(b * 2 + 1) * DFF + f0 + e]; }
            if (t >= 2) unpack8(*(const v4u*)(F.UG + (size_t)(row - 2) * NUG + pc), u0); else {
#pragma unroll
                for (int e = 0; e < 8; ++e) u0[e] = F.st_f[(size_t)(b * 2 + t) * DFF + f0 + e]; }
        }
#pragma unroll
        for (int e = 0; e < 8; ++e) { const float cv = F.conv_f_w[f0 + e] * u0[e] + F.conv_f_w[DFF + f0 + e] * u1[e] + F.conv_f_w[2 * DFF + f0 + e] * u2[e] + F.conv_f_b[f0 + e]; r[e] = gelu_tanh(cv) * gg[e]; }
        *(v4u*)(F.HC + (size_t)row * DFF + f0) = pack8(r);
    }
}

struct Args { const void* in[24]; float* out; unsigned char* ws; int ph_lo, ph_hi; };
__global__ void __launch_bounds__(NWAVES * 64, 2) hybrid_fwd(Args args) {
    extern __shared__ __attribute__((aligned(16))) unsigned char lds[];
    Frame F;
    F.lds = (LAS unsigned char*)lds;
    F.tid = threadIdx.x; F.lane = F.tid & 63; F.wave = __builtin_amdgcn_readfirstlane(F.tid >> 6);
    F.G = gridDim.x; F.gw = blockIdx.x * NWAVES + F.wave; F.NGW = F.G * NWAVES;
    unsigned char* ws = args.ws;
    F.x_p = (const float*)args.in[0]; F.x_s = (const float*)args.in[1]; F.cache_k = (const float*)args.in[2]; F.cache_v = (const float*)args.in[3]; F.cache_ik = (const float*)args.in[4];
    F.st_a = (const float*)args.in[5]; F.st_f = (const float*)args.in[6]; F.ptab = (const int*)args.in[7]; F.w_in = (const float*)args.in[8]; F.ikg = (const float*)args.in[9]; F.ikb = (const float*)args.in[10];
    F.conv_a_w = (const float*)args.in[11]; F.w_a_out = (const float*)args.in[12]; F.w_attn_out = (const float*)args.in[13]; F.w_mix_out = (const float*)args.in[14]; F.ln1g = (const float*)args.in[15]; F.ln1b = (const float*)args.in[16];
    F.w_up = (const float*)args.in[17]; F.w_gate = (const float*)args.in[18]; F.conv_f_w = (const float*)args.in[19]; F.conv_f_b = (const float*)args.in[20]; F.w_down = (const float*)args.in[21]; F.ln2g = (const float*)args.in[22]; F.ln2b = (const float*)args.in[23];
    F.out = args.out;
    F.WIN = (bf16*)(ws + WS_WIN); F.WAOUT = (bf16*)(ws + WS_WAOUT); F.WATTN = (bf16*)(ws + WS_WATTN); F.WMIX = (bf16*)(ws + WS_WMIX); F.WUG = (bf16*)(ws + WS_WUG); F.WDOWN = (bf16*)(ws + WS_WDOWN);
    F.XB = (bf16*)(ws + WS_XB); F.CB = (bf16*)(ws + WS_CB); F.CCH = (bf16*)(ws + WS_CCH); F.QB = (bf16*)(ws + WS_QB); F.KB = (bf16*)(ws + WS_KB); F.VB = (bf16*)(ws + WS_VB); F.IQB = (bf16*)(ws + WS_IQB);
    F.IKB = (bf16*)(ws + WS_IKB); F.IW = (float*)(ws + WS_IW); F.SGA = (bf16*)(ws + WS_SGA); F.SGB = (bf16*)(ws + WS_SGB); F.A2 = (bf16*)(ws + WS_A2); F.MA = (bf16*)(ws + WS_MA); F.OB = (bf16*)(ws + WS_OB); F.MB = (bf16*)(ws + WS_MB);
    F.PRE1 = (float*)(ws + WS_PRE1); F.X1 = (float*)(ws + WS_X1); F.X1B = (bf16*)(ws + WS_X1B); F.UG = (bf16*)(ws + WS_UG); F.HC = (bf16*)(ws + WS_HC); F.ZS = (float*)(ws + WS_ZS); F.YAS = (float*)(ws + WS_YAS);
    F.SSC = (float*)(ws + WS_SSC); F.ROPEA = (f32x2*)(ws + WS_ROPEA); F.ROPEB = (f32x2*)(ws + WS_ROPEB); F.MASK = (unsigned long long*)(ws + WS_MASK);
    for (int u = F.tid; u < (LDS_BYTES - LDSCTL_OFF) / 4; u += NWAVES * 64) ((LAS unsigned*)(F.lds + LDSCTL_OFF))[u] = 0u;
    __syncthreads();
    unsigned* barw = (unsigned*)(ws + WS_CTL) + CW_BAR;
    XcdBarrier bar; bar.bar = barw; bar.x = 0; bar.st = nullptr;
    if (MK_N_LAUNCHES == 1) bar = xcd_barrier_post(barw, (volatile LAS unsigned*)(F.lds + MISC_OFF) + 8);
    const int lo = args.ph_lo, hi = args.ph_hi;
#define IN(k) (lo <= (k) && (k) < hi)
#define SEAM(k) do { if (IN(k) && IN((k) + 1)) { if (MK_N_LAUNCHES == 1) xcd_barrier(bar); } } while (0)
    LAS unsigned char* ring = F.lds;

    if (IN(0)) { p0_prologue(F); }
    SEAM(0);
    if (IN(1)) {
        pg8::Gemm g{F.XB, F.WIN, MP, NZ, DM}; pg8::StaticOrder S; S.init(MP, NZ, F.G, (int)blockIdx.x);
        EpiZ E{F.CB, F.CCH, F.QB, F.KB, F.VB, F.IQB, F.SGA, F.SGB, F.out + O_KP, F.out + O_VP, F.out + O_CAP, F.ROPEA, F.ROPEB};
        pg8::gemm_phase<EpiZ, pg8::StaticOrder, true, true>(ring, g, S, E);
        __syncthreads();
        ikiw_phase(F);
        skinny_gemm<3>(F, F.XB + (size_t)MP * DM, F.WIN, DM, NZ / 16, EpiRawF32{F.ZS, NZ});
    }
    SEAM(1);
    if (IN(2)) { p2_pointwise(F); }
    SEAM(2);
    if (IN(3)) {
        pg8::Gemm g{F.A2, F.WAOUT, MP, DM, DCONV}; pg8::StaticOrder S; S.init(MP, DM, F.G, (int)blockIdx.x);
        EpiMerge<0> E{F.SGA, nullptr, F.MA};
        pg8::gemm_phase<EpiMerge<0>, pg8::StaticOrder, true, true>(ring, g, S, E);
        __syncthreads();
        skinny_gemm<1>(F, F.A2 + (size_t)MP * DCONV, F.WAOUT, DCONV, DM / 16, EpiRawF32{F.YAS, DM});
        sample_scores(F);
    }
    SEAM(3);
    if (IN(4)) {
        __syncthreads();
        sample_attend(F);
        __syncthreads();
        naive_prompt_attention(F);
    }
    SEAM(4);
    if (IN(5)) {
        pg8::Gemm g{F.OB, F.WATTN, MP, DM, DQ}; pg8::StaticOrder S; S.init(MP, DM, F.G, (int)blockIdx.x);
        EpiMerge<1> E{F.SGB, F.MA, F.MB};
        pg8::gemm_phase<EpiMerge<1>, pg8::StaticOrder, true, true>(ring, g, S, E);
        __syncthreads();
        const bf16* sga = F.SGA + (size_t)MP * DM; const bf16* sgb = F.SGB + (size_t)MP * DM; const float* yas = F.YAS; bf16* mb = F.MB + (size_t)MP * DM;
        auto epi = [=](int r, int c, f32x4 v) { const size_t o = (size_t)r * DM + c; const v2u ga = *(const v2u*)(sga + o), gb = *(const v2u*)(sgb + o); const f32x4 ya = *(const f32x4*)(yas + o);
            v2u w; w.x = pk2(bflo(ga.x) * ya[0] + bflo(gb.x) * v[0], bfhi(ga.x) * ya[1] + bfhi(gb.x) * v[1]); w.y = pk2(bflo(ga.y) * ya[2] + bflo(gb.y) * v[2], bfhi(ga.y) * ya[3] + bfhi(gb.y) * v[3]); *(v2u*)(mb + o) = w; };
        skinny_gemm<1>(F, F.OB + (size_t)MP * DQ, F.WATTN, DQ, DM / 16, epi);
    }
    SEAM(5);
    if (IN(6)) {
        pg8::Gemm g{F.MB, F.WMIX, MP, DM, DM}; pg8::StaticOrder S; S.init(MP, DM, F.G, (int)blockIdx.x);
        EpiResid E{F.x_p, F.PRE1};
        pg8::gemm_phase<EpiResid, pg8::StaticOrder, true, true>(ring, g, S, E);
        __syncthreads();
        const float* xs = F.x_s; float* pre = F.PRE1 + (size_t)MP * DM;
        auto epi = [=](int r, int c, f32x4 v) { const size_t o = (size_t)r * DM + c; *(f32x4*)(pre + o) = *(const f32x4*)(xs + o) * ALPHA + v; };
        skinny_gemm<1>(F, F.MB + (size_t)MP * DM, F.WMIX, DM, DM / 16, epi);
    }
    SEAM(6);
    if (IN(7)) { ln_rows<true>(F, F.PRE1, F.X1, F.X1B, F.ln1g, F.ln1b); }
    SEAM(7);
    if (IN(8)) {
        pg8::Gemm g{F.X1B, F.WUG, MP, NUG, DM}; pg8::StaticOrder S; S.init(MP, NUG, F.G, (int)blockIdx.x);
        EpiUG E{F.UG, F.out + O_CFP};
        pg8::gemm_phase<EpiUG, pg8::StaticOrder, true, true>(ring, g, S, E);
        __syncthreads();
        bf16* ug = F.UG + (size_t)MP * NUG; float* cfs = F.out + O_CFS;
        auto epi = [=](int r, int c, f32x4 v) { v2u w; w.x = pk2(v[0], v[1]); w.y = pk2(v[2], v[3]); *(v2u*)(ug + (size_t)r * NUG + c) = w;
            const int t = r & 3; if ((c & 128) == 0 && t >= 2) *(f32x4*)(cfs + (size_t)((r >> 2) * 2 + (t - 2)) * DFF + ((c >> 8) << 7) + (c & 127)) = v; };
        skinny_gemm<3>(F, F.X1B + (size_t)MP * DM, F.WUG, DM, NUG / 16, epi);
    }
    SEAM(8);
    if (IN(9)) { hc_pass(F); }
    SEAM(9);
    if (IN(10)) {
        pg8::Gemm g{F.HC, F.WDOWN, MP, DM, DFF}; pg8::StaticOrder S; S.init(MP, DM, F.G, (int)blockIdx.x);
        EpiResid E{F.X1, F.out + O_Y};
        pg8::gemm_phase<EpiResid, pg8::StaticOrder, true, true>(ring, g, S, E);
        __syncthreads();
        const float* x1 = F.X1 + (size_t)MP * DM; float* yo = F.out + O_Y + (size_t)MP * DM;
        auto epi = [=](int r, int c, f32x4 v) { const size_t o = (size_t)r * DM + c; *(f32x4*)(yo + o) = *(const f32x4*)(x1 + o) * ALPHA + v; };
        skinny_gemm<1>(F, F.HC + (size_t)MP * DFF, F.WDOWN, DFF, DM / 16, epi);
    }
    SEAM(10);
    if (IN(11)) { ln_rows<false>(F, F.out + O_Y, F.out + O_Y, nullptr, F.ln2g, F.ln2b); }
#undef IN
#undef SEAM
}

extern "C" void kernel_launch(void* const* d_in, const int* in_sizes, int n_in, void* d_out, int out_size, void* d_ws, size_t ws_size, hipStream_t stream) {
    static int grid = 0;
    if (grid == 0) {
        if (n_in != 24 || out_size != (int)O_END || ws_size < WS_END) { fprintf(stderr, "kernel_launch: unexpected shapes (n_in %d, out %d, ws %zu); nothing launched\n", n_in, out_size, ws_size); grid = -1; return; }
        int dev = 0, cus = 0, per_cu = 0;
        if (hipGetDevice(&dev) != hipSuccess || hipDeviceGetAttribute(&cus, hipDeviceAttributeMultiprocessorCount, dev) != hipSuccess) { grid = -1; return; }
        if (hipFuncSetAttribute((const void*)hybrid_fwd, hipFuncAttributeMaxDynamicSharedMemorySize, LDS_BYTES) != hipSuccess) { fprintf(stderr, "kernel_launch: hipFuncSetAttribute failed\n"); grid = -1; return; }
        if (hipOccupancyMaxActiveBlocksPerMultiprocessor(&per_cu, (const void*)hybrid_fwd, NWAVES * 64, LDS_BYTES) != hipSuccess || per_cu < 1) { fprintf(stderr, "kernel_launch: occupancy query reports %d blocks per CU\n", per_cu); }
        (void)hipGetLastError();
        grid = cus;
    }
    if (grid < 0) return;
    (void)hipMemsetAsync((char*)d_ws + WS_CTL, 0, CTL_ZERO_BYTES, stream);
    Args a{};
    for (int i = 0; i < 24; ++i) a.in[i] = d_in[i];
    a.out = (float*)d_out; a.ws = (unsigned char*)d_ws;
    if (MK_N_LAUNCHES == 1) { a.ph_lo = 0; a.ph_hi = N_PHASES; hipLaunchKernelGGL(hybrid_fwd, dim3(grid), dim3(NWAVES * 64), LDS_BYTES, stream, a); }
    else for (int p = 0; p < N_PHASES; ++p) { a.ph_lo = p; a.ph_hi = p + 1; hipLaunchKernelGGL(hybrid_fwd, dim3(grid), dim3(NWAVES * 64), LDS_BYTES, stream, a); }
}
```

```cpp
#include <hip/hip_runtime.h>
#include <cstdio>
#include <cstdint>
namespace pg8 {
#define PG8_LAS __attribute__((address_space(3)))
typedef unsigned short bf16_t;
typedef short bf16x8 __attribute__((ext_vector_type(8)));
typedef float f32x4 __attribute__((ext_vector_type(4)));
typedef unsigned u32x4 __attribute__((ext_vector_type(4)));
constexpr int BM = 256, BK = 64, HALF = 128, HTB = HALF * BK * 2  , STAGE_BYTES = 8 * HTB, NXCD = 8, WGM = 8;

__host__ __device__ __forceinline__ int lds_byte(int r, int c) { const int st = (r >> 4) * 2 + (c >> 5), rr = r & 15, cc = c & 31, ob = rr * 64 + cc * 2; return st * 1024 + (ob ^ (((ob >> 9) & 1) << 5)); }
__host__ __device__ __forceinline__ void stage_rc(int b, int& R, int& C) { const int st = b / 1024, sb = b % 1024, swz = sb ^ (((sb >> 9) & 1) << 5); R = (st >> 1) * 16 + swz / 64; C = (st & 1) * 32 + (swz % 64) / 2; }
__host__ __device__ __forceinline__ int perm32(int rho) { const int n = rho >> 4, i = rho & 15; return 8 * (i >> 2) + 4 * n + (i & 3); }

struct Unit { int pm, pn; };
struct Gemm { const bf16_t* A; const bf16_t* Bt; int M, N, K; };

struct StaticOrder {
    int nM, nN, nwg, G, c;
    __host__ __device__ void init(int M, int N, int G_, int c_) { nM = M / BM; nN = N / BM; nwg = nM * nN; G = G_; c = c_; }
    __host__ __device__ bool next(int i, Unit& u) const {
        const long L = (long)i * G + c; if (L >= nwg) return false;
        int wgid = (int)L; { const int q = nwg / NXCD, r = nwg % NXCD, xcd = wgid % NXCD, off = wgid / NXCD; wgid = (xcd < r ? xcd * (q + 1) : r * (q + 1) + (xcd - r) * q) + off; }
        const int nig = WGM * nN, gid = wgid / nig, fm = gid * WGM, gsz = (nM - fm) < WGM ? (nM - fm) : WGM;
        u.pm = fm + ((wgid % nig) % gsz); u.pn = (wgid % nig) / gsz; return true;
    }
    __device__ __forceinline__ void a_ready(const Unit&) const {}
    __device__ __forceinline__ void done(const Unit&) const {}
};

typedef __bf16 bf16x2_hw __attribute__((ext_vector_type(2))); typedef float f32x2_hw __attribute__((ext_vector_type(2)));
__device__ __forceinline__ unsigned cvt_pk_bf16(float lo, float hi) { const f32x2_hw v = {lo, hi}; return __builtin_bit_cast(unsigned, __builtin_convertvector(v, bf16x2_hw)); }
template <class Epi, class Sched, bool ALIGN_EPI = false, bool SP2 = false>
__device__ __forceinline__ void gemm_phase(PG8_LAS unsigned char* lds, const Gemm g, const Sched& S, const Epi& E) {
    const int tid = threadIdx.x, wid = __builtin_amdgcn_readfirstlane(tid >> 6), lane = tid & 63, wr = wid >> 2, wc = wid & 3, fr = lane & 15, fq = lane >> 4;
    const int K = g.K, nt = K / BK;
    unsigned voffA[2], voffB[2];
#pragma unroll
    for (int i = 0; i < 2; ++i) { int R, C; stage_rc(tid * 16 + i * 8192, R, C); const int Rb = Epi::PERM ? ((R & ~31) + perm32(R & 31)) : R;
        voffA[i] = (unsigned)(R * K + C) * 2u; voffB[i] = (unsigned)(Rb * K + C) * 2u; }
    const size_t kstep = (size_t)(BK * 2);
    const size_t hstep = (size_t)HALF * K * 2;
    const size_t tstep = 2 * hstep;
    const unsigned ldsw = (unsigned)wid * 1024u;
    const int aoff = lds_byte(wr * 64 + fr, fq * 8), boff = lds_byte(wc * 32 + fr, fq * 8);
#define PG8_SA(b, h) (((b) * 2 + (h)) * HTB)
#define PG8_SB(b, h) ((4 + (b) * 2 + (h)) * HTB)
#define PG8_STAGE(bufoff, gbase, voff) do { _Pragma("unroll") for (int _i = 0; _i < 2; ++_i) \
        __builtin_amdgcn_global_load_lds((const unsigned*)((const char*)(gbase) + (voff)[_i]), (PG8_LAS unsigned*)(lds + (bufoff) + ldsw + _i * 8192), 16, 0, 0); } while (0)
#define PG8_LDA(dst, b, h) do { _Pragma("unroll") for (int m = 0; m < 4; ++m) _Pragma("unroll") for (int k = 0; k < 2; ++k) dst[m][k] = *(const PG8_LAS bf16x8*)(lds + PG8_SA(b, h) + aoff + m * 2048 + k * 1024); } while (0)
#define PG8_LDB(dst, b, h) do { _Pragma("unroll") for (int n = 0; n < 2; ++n) _Pragma("unroll") for (int k = 0; k < 2; ++k) dst[n][k] = *(const PG8_LAS bf16x8*)(lds + PG8_SB(b, h) + boff + n * 2048 + k * 1024); } while (0)
#define PG8_MMA(ai, bj, At, Bt) do { __builtin_amdgcn_s_setprio(1); _Pragma("unroll") for (int m = 0; m < 4; ++m) _Pragma("unroll") for (int n = 0; n < 2; ++n) _Pragma("unroll") for (int k = 0; k < 2; ++k) \
        acc[ai][bj][m][n] = __builtin_amdgcn_mfma_f32_16x16x32_bf16(Bt[n][k], At[m][k], acc[ai][bj][m][n], 0, 0, 0); __builtin_amdgcn_s_setprio(0); } while (0)
#define PG8_WAIT_V(n) asm volatile("s_waitcnt vmcnt(" #n ")" ::: "memory")
#define PG8_WAIT_L(n) asm volatile("s_waitcnt lgkmcnt(" #n ")" ::: "memory")
#define PG8_BAR __builtin_amdgcn_s_barrier()
#define PG8_SCHED __builtin_amdgcn_sched_barrier(0)
    Unit cur, nxt; int ui = 0;
    if (!S.next(0, cur)) return;
    f32x4 acc[2][2][4][2];
#pragma unroll
    for (int a = 0; a < 2; ++a)
#pragma unroll
        for (int b = 0; b < 2; ++b)
#pragma unroll
            for (int m = 0; m < 4; ++m)
#pragma unroll
                for (int n = 0; n < 2; ++n) acc[a][b][m][n] = (f32x4){0.f, 0.f, 0.f, 0.f};
    bf16x8 At[4][2], B0[2][2], B1[2][2];
    const char* cA = (const char*)g.A + (size_t)cur.pm * tstep; const char* cB = (const char*)g.Bt + (size_t)cur.pn * tstep;
    S.a_ready(cur);
    if constexpr (SP2) {
        PG8_STAGE(PG8_SB(0, 0), cB, voffB); PG8_STAGE(PG8_SB(0, 1), cB + hstep, voffB); PG8_STAGE(PG8_SA(0, 0), cA, voffA); PG8_STAGE(PG8_SA(0, 1), cA + hstep, voffA);
        if (wr == 1) PG8_BAR;
        PG8_WAIT_V(2); PG8_BAR;
        PG8_STAGE(PG8_SB(1, 0), cB + kstep, voffB); PG8_STAGE(PG8_SA(1, 0), cA + kstep, voffA); PG8_STAGE(PG8_SB(1, 1), cB + hstep + kstep, voffB);
        PG8_WAIT_V(6); PG8_BAR;
    } else {
        PG8_STAGE(PG8_SB(0, 0), cB, voffB); PG8_STAGE(PG8_SA(0, 0), cA, voffA); PG8_STAGE(PG8_SB(0, 1), cB + hstep, voffB); PG8_STAGE(PG8_SA(0, 1), cA + hstep, voffA);
        if (wr == 1) PG8_BAR;
        PG8_WAIT_V(4); PG8_BAR;
        PG8_STAGE(PG8_SB(1, 0), cB + kstep, voffB); PG8_STAGE(PG8_SA(1, 0), cA + kstep, voffA); PG8_STAGE(PG8_SB(1, 1), cB + hstep + kstep, voffB);
        PG8_WAIT_V(6); PG8_BAR;
    }
    for (;;) {
        const bool has_next = S.next(ui + 1, nxt);
        const char* nA = has_next ? (const char*)g.A + (size_t)nxt.pm * tstep : cA; const char* nB = has_next ? (const char*)g.Bt + (size_t)nxt.pn * tstep : cB;
        for (int t = 0; t < nt; t += 2) {
            const bool last = (t == nt - 2);
            const char* a1 = cA + (size_t)(t + 1) * kstep;
            const char* a2 = last ? nA : cA + (size_t)(t + 2) * kstep; const char* b2 = last ? nB : cB + (size_t)(t + 2) * kstep;
            const char* a3 = a2 + kstep; const char* b3 = b2 + kstep;
            if (last && has_next) S.a_ready(nxt);
            if constexpr (SP2) {
            PG8_LDB(B0, 0, 0); PG8_LDB(B1, 0, 1); PG8_SCHED; PG8_LDA(At, 0, 0); PG8_STAGE(PG8_SA(1, 1), a1 + hstep, voffA);
            PG8_WAIT_V(8); PG8_WAIT_L(0); PG8_BAR; PG8_MMA(0, 0, At, B0); PG8_MMA(0, 1, At, B1); PG8_BAR; PG8_SCHED;
            PG8_LDA(At, 0, 1); PG8_STAGE(PG8_SB(0, 0), b2, voffB); PG8_STAGE(PG8_SB(0, 1), b2 + hstep, voffB); PG8_STAGE(PG8_SA(0, 0), a2, voffA);
            PG8_WAIT_V(8); PG8_WAIT_L(0); PG8_BAR; PG8_MMA(1, 0, At, B0); PG8_MMA(1, 1, At, B1); PG8_BAR; PG8_SCHED;
            PG8_LDB(B0, 1, 0); PG8_LDB(B1, 1, 1); PG8_SCHED; PG8_LDA(At, 1, 0); PG8_STAGE(PG8_SA(0, 1), a2 + hstep, voffA);
            PG8_WAIT_V(8); PG8_WAIT_L(0); PG8_BAR; PG8_MMA(0, 0, At, B0); PG8_MMA(0, 1, At, B1); PG8_BAR; PG8_SCHED;
            PG8_LDA(At, 1, 1); PG8_STAGE(PG8_SB(1, 0), b3, voffB); PG8_STAGE(PG8_SB(1, 1), b3 + hstep, voffB); PG8_STAGE(PG8_SA(1, 0), a3, voffA);
            PG8_WAIT_V(8); PG8_WAIT_L(0); PG8_BAR; PG8_MMA(1, 0, At, B0); PG8_MMA(1, 1, At, B1); PG8_BAR; PG8_SCHED;
            } else {
            PG8_LDB(B0, 0, 0); PG8_SCHED; PG8_LDA(At, 0, 0); PG8_STAGE(PG8_SA(1, 1), a1 + hstep, voffA);
            PG8_WAIT_L(8); PG8_BAR; PG8_WAIT_L(0); PG8_MMA(0, 0, At, B0); PG8_BAR; PG8_SCHED;
            PG8_LDB(B1, 0, 1); PG8_STAGE(PG8_SB(0, 0), b2, voffB);
            PG8_BAR; PG8_WAIT_L(0); PG8_MMA(0, 1, At, B1); PG8_BAR;
            PG8_LDA(At, 0, 1); PG8_STAGE(PG8_SA(0, 0), a2, voffA);
            PG8_BAR; PG8_WAIT_L(0); PG8_MMA(1, 0, At, B0); PG8_BAR; PG8_SCHED;
            PG8_STAGE(PG8_SB(0, 1), b2 + hstep, voffB);
            PG8_WAIT_V(6); PG8_BAR; PG8_MMA(1, 1, At, B1); PG8_BAR;
            PG8_LDB(B0, 1, 0); PG8_SCHED; PG8_LDA(At, 1, 0); PG8_STAGE(PG8_SA(0, 1), a2 + hstep, voffA);
            PG8_WAIT_L(8); PG8_BAR; PG8_WAIT_L(0); PG8_MMA(0, 0, At, B0); PG8_BAR; PG8_SCHED;
            PG8_LDB(B1, 1, 1); PG8_STAGE(PG8_SB(1, 0), b3, voffB);
            PG8_BAR; PG8_WAIT_L(0); PG8_MMA(0, 1, At, B1); PG8_BAR;
            PG8_LDA(At, 1, 1); PG8_STAGE(PG8_SA(1, 0), a3, voffA);
            PG8_BAR; PG8_WAIT_L(0); PG8_MMA(1, 0, At, B0); PG8_BAR; PG8_SCHED;
            PG8_STAGE(PG8_SB(1, 1), b3 + hstep, voffB);
            PG8_WAIT_V(6); PG8_BAR; PG8_MMA(1, 1, At, B1); PG8_BAR;
            }
        }
        if constexpr (ALIGN_EPI) { if (wr == 0) PG8_BAR; }
        if constexpr (!Epi::AFTER_DRAIN) { E(acc, cur, wr, wc, fr, fq); S.done(cur); }
        if (!has_next) break;
#pragma unroll
        for (int a = 0; a < 2; ++a)
#pragma unroll
            for (int b = 0; b < 2; ++b)
#pragma unroll
                for (int m = 0; m < 4; ++m)
#pragma unroll
                    for (int n = 0; n < 2; ++n) acc[a][b][m][n] = (f32x4){0.f, 0.f, 0.f, 0.f};
        cur = nxt; cA = nA; cB = nB; ++ui;
        if constexpr (ALIGN_EPI) { if (wr == 1) PG8_BAR; }
    }
    PG8_WAIT_V(0);
    if constexpr (!ALIGN_EPI) { if (wr == 0) PG8_BAR; }
    PG8_BAR;
    if constexpr (Epi::AFTER_DRAIN) { E.fused(acc, cur, wr, wc, fr, fq, lds, wid, lane); S.done(cur); }
#undef PG8_SA
#undef PG8_SB
#undef PG8_STAGE
#undef PG8_LDA
#undef PG8_LDB
#undef PG8_MMA
#undef PG8_WAIT_V
#undef PG8_WAIT_L
#undef PG8_BAR
#undef PG8_SCHED
}
}

#ifndef MK_N_LAUNCHES
#define MK_N_LAUNCHES 1
#endif
constexpr int NWAVES = 8;
constexpr int N_PHASES = 12;

constexpr int DM = 2048, NBATCH = 8, SEQ = 2048, MP = NBATCH * SEQ, DECB = 32, DECS = 4, MS = DECB * DECS, MALL = MP + MS;
constexpr int PAST = 8192, PAGE = 128, NPAGES = PAST / PAGE;
constexpr int DCONV = 1024, NKV = 4, HD = 128, NIH = 16, IDD = 64, TOPK = 256, DFF = 5632;
constexpr int DQ = 2048, DKV = 512, DIQ = 1024, DIN = 11344;
constexpr int NZ = 11264;
constexpr int NUG = 2 * DFF;
constexpr int SSC_PITCH = 8256;
constexpr float LN_EPS = 1e-5f;
constexpr float ALPHA = 1.189207115002721f;

constexpr size_t O_Y = 0, O_KP = 33816576, O_VP = 42205184, O_IKP = 50593792, O_CAP = 51642368, O_CFP = 51658752,
                 O_KS = 51748864, O_VS = 51814400, O_IKS = 51879936, O_CAS = 51888128, O_CFS = 51953664, O_END = 52314112;

constexpr size_t MiB = 1u << 20;
constexpr size_t WS_CTL = 0, CTL_ZERO_BYTES = 32768;
constexpr size_t WS_ROPEA = 1 * MiB, WS_ROPEB = 1 * MiB + 512 * 1024;
constexpr size_t WS_WIN = 2 * MiB, WS_WAOUT = 48 * MiB, WS_WATTN = 52 * MiB, WS_WMIX = 60 * MiB, WS_WUG = 68 * MiB, WS_WDOWN = 112 * MiB;
constexpr size_t WS_XB = 136 * MiB, WS_CB = 202 * MiB, WS_CCH = 235 * MiB, WS_QB = 268 * MiB, WS_KB = 334 * MiB, WS_VB = 351 * MiB, WS_IQB = 368 * MiB;
constexpr size_t WS_IKB = 401 * MiB, WS_IW = 404 * MiB, WS_SGA = 406 * MiB, WS_SGB = 472 * MiB, WS_A2 = 538 * MiB, WS_MA = 571 * MiB, WS_OB = 637 * MiB, WS_MB = 703 * MiB;
constexpr size_t WS_PRE1 = 769 * MiB, WS_PRE2 = 840 * MiB, WS_STATS = 910 * MiB, WS_X1B = 1029 * MiB, WS_UG = 1095 * MiB, WS_HC = 1451 * MiB, WS_ZS = 1629 * MiB, WS_YAS = 1635 * MiB;
constexpr size_t WS_SSC = 1636 * MiB, WS_MASK = 1641 * MiB, WS_END = 1645 * MiB;
constexpr int CW_BAR = 4096;

constexpr int RING_BYTES = 135168;
constexpr int LDSCTL_OFF = RING_BYTES, MISC_OFF = LDSCTL_OFF + 320;
constexpr int HALO_OFF = MISC_OFF + 128;
constexpr int LDS_BYTES = 147456;

#define GAS __attribute__((address_space(1)))
#define LAS __attribute__((address_space(3)))
typedef unsigned short bf16;
typedef unsigned v4u __attribute__((ext_vector_type(4)));
typedef unsigned v2u __attribute__((ext_vector_type(2)));
typedef float f32x4 __attribute__((ext_vector_type(4)));
typedef float f32x2 __attribute__((ext_vector_type(2)));
typedef short bf16x8 __attribute__((ext_vector_type(8)));
#define LDS_WAIT() asm volatile("s_waitcnt lgkmcnt(0)" ::: "memory")
#define VM_WAIT() asm volatile("s_waitcnt vmcnt(0)" ::: "memory")
__device__ __forceinline__ unsigned f2bf(float f) { unsigned u = __builtin_bit_cast(unsigned, f); return (u + 0x7fffu + ((u >> 16) & 1u)) >> 16; }
__device__ __forceinline__ unsigned pk2(float lo, float hi) { return pg8::cvt_pk_bf16(lo, hi); }
__device__ __forceinline__ float bflo(unsigned w) { return __builtin_bit_cast(float, w << 16); }
__device__ __forceinline__ float bfhi(unsigned w) { return __builtin_bit_cast(float, w & 0xffff0000u); }
__device__ __forceinline__ float bf1(bf16 h) { return __builtin_bit_cast(float, ((unsigned)h) << 16); }
__device__ __forceinline__ void unpack8(v4u w, float (&f)[8]) { f[0] = bflo(w.x); f[1] = bfhi(w.x); f[2] = bflo(w.y); f[3] = bfhi(w.y); f[4] = bflo(w.z); f[5] = bfhi(w.z); f[6] = bflo(w.w); f[7] = bfhi(w.w); }
__device__ __forceinline__ v4u pack8(const float (&f)[8]) { v4u w; w.x = pk2(f[0], f[1]); w.y = pk2(f[2], f[3]); w.z = pk2(f[4], f[5]); w.w = pk2(f[6], f[7]); return w; }
__device__ __forceinline__ void zero8(float (&f)[8]) { f[0] = f[1] = f[2] = f[3] = f[4] = f[5] = f[6] = f[7] = 0.f; }
__device__ __forceinline__ float sigmoidf_(float x) { return __builtin_amdgcn_rcpf(1.0f + __builtin_amdgcn_exp2f(-1.4426950408889634f * x)); }
__device__ __forceinline__ float sigmoid_fast(float x) { return sigmoidf_(x); }
__device__ __forceinline__ float gelu_tanh(float x) { const float p = __builtin_fmaf(x * x, 0.10294324f, 2.3022082f); const float r = __builtin_amdgcn_rcpf(__builtin_amdgcn_exp2f(x * p) + 1.0f); return __builtin_fmaf(-x, r, x); }
__device__ __forceinline__ float wave_sum(float v) {
#pragma unroll
    for (int o = 1; o < 64; o <<= 1) v += __shfl_xor(v, o);
    return v;
}
__device__ __forceinline__ float wave_max(float v) {
#pragma unroll
    for (int o = 1; o < 64; o <<= 1) v = fmaxf(v, __shfl_xor(v, o));
    return v;
}
__device__ __forceinline__ int pos_index(int row) { return row < MP ? (row & (SEQ - 1)) : SEQ + ((row - MP) & (DECS - 1)); }

#define XB_TMO      128
#define XB_XCNT(j)  (256  + 64 * (j))
#define XB_XSUB(j)  (1280 + 64 * (j))
#define XB_XGEN(j)  (2304 + 64 * (j))
#define XB_TOP      3328
#define XB_TOPGEN   3392
#define XCD_BAR_WORDS 3456
#define XB_SPIN_CAP (1u << 18)

__device__ __forceinline__ unsigned xb_ld(unsigned* p)              { return __hip_atomic_load(p, __ATOMIC_RELAXED, __HIP_MEMORY_SCOPE_AGENT); }
__device__ __forceinline__ unsigned xb_add(unsigned* p, unsigned v) { return __hip_atomic_fetch_add(p, v, __ATOMIC_RELAXED, __HIP_MEMORY_SCOPE_AGENT); }
__device__ __forceinline__ unsigned xb_xcc_id() { return (unsigned)__builtin_amdgcn_s_getreg((3 << 11) | 20) & 0xFu; }
#define XB_SPIN(cond, bar) do { unsigned _sp = 0; while (cond) { __builtin_amdgcn_s_sleep(1); \
    if ((++_sp & 255u) == 0u) { if (xb_ld(&(bar)[XB_TMO])) break; if (_sp > XB_SPIN_CAP) { atomicAdd(&(bar)[XB_TMO], 1u); break; } } } } while (0)

struct XcdBarrier {
    unsigned* bar; unsigned x;
    volatile LAS unsigned* st;
};

__device__ __forceinline__ XcdBarrier xcd_barrier_post(unsigned* bar, volatile LAS unsigned* st) {
    XcdBarrier b; b.bar = bar; b.x = xb_xcc_id(); b.st = st;
    if (threadIdx.x == 0) (void)xb_add(&bar[XB_XCNT(b.x)], 1u);
    return b;
}
__device__ __forceinline__ void xcd_barrier_complete(unsigned* bar, unsigned x, unsigned& nloc, unsigned& nx) {
    const unsigned G = gridDim.x * gridDim.y * gridDim.z;
    unsigned sum, cnt, mine, sp = 0u;
    for (;;) {
        sum = 0u; cnt = 0u; mine = 0u;
#pragma unroll
        for (unsigned j = 0; j < 16; ++j) { const unsigned c = xb_ld(&bar[XB_XCNT(j)]); sum += c; cnt += (c > 0u) ? 1u : 0u; mine = (j == x) ? c : mine; }
        if (sum == G) break;
        __builtin_amdgcn_s_sleep(1);
        if ((++sp & 255u) == 0u) { if (xb_ld(&bar[XB_TMO])) break; if (sp > XB_SPIN_CAP) { atomicAdd(&bar[XB_TMO], 1u); break; } }
    }
    nloc = mine > 0u ? mine : 1u; nx = cnt > 0u ? cnt : 1u;
}

__device__ __forceinline__ void xcd_barrier(const XcdBarrier& b) {
    asm volatile("s_waitcnt vmcnt(0)" ::: "memory");
    __syncthreads();
    if (threadIdx.x == 0) {
        unsigned* bar = b.bar;
        __builtin_amdgcn_s_waitcnt(0);
        unsigned nloc = b.st[0], nx = b.st[1];
        if (nloc == 0u) { xcd_barrier_complete(bar, b.x, nloc, nx); b.st[0] = nloc; b.st[1] = nx; }
        const unsigned old = xb_add(&bar[XB_XSUB(b.x)], 1u);
        const unsigned gen = old / nloc;
        if (old + 1u == (gen + 1u) * nloc) {
            __builtin_amdgcn_fence(__ATOMIC_RELEASE, "agent");
            asm volatile("s_waitcnt vmcnt(0)" ::: "memory");
            const unsigned og = xb_add(&bar[XB_TOP], 1u);
            const unsigned tg = og / nx;
            if (og + 1u == (tg + 1u) * nx) xb_add(&bar[XB_TOPGEN], 1u);
            else XB_SPIN(xb_ld(&bar[XB_TOPGEN]) == tg, bar);
            __builtin_amdgcn_fence(__ATOMIC_ACQUIRE, "agent");
            xb_add(&bar[XB_XGEN(b.x)], 1u);
            asm volatile("s_waitcnt vmcnt(0)" ::: "memory");
        } else {
            XB_SPIN(xb_ld(&bar[XB_XGEN(b.x)]) == gen, bar);
            __builtin_amdgcn_fence(__ATOMIC_ACQUIRE, "agent");
            asm volatile("s_waitcnt vmcnt(0)" ::: "memory");
        }
    }
    __syncthreads();
}

#define CAS __attribute__((address_space(4)))
struct Args { const void* in[24]; float* out; unsigned char* ws; int ph_lo, ph_hi; };
struct Frame {
    LAS unsigned char* lds;
    int tid, lane, wave, G, gw, NGW;
    const Args CAS* a;
    __device__ __forceinline__ bf16* WIN() const { return (bf16*)(a->ws + WS_WIN); }
    __device__ __forceinline__ bf16* WAOUT() const { return (bf16*)(a->ws + WS_WAOUT); }
    __device__ __forceinline__ bf16* WATTN() const { return (bf16*)(a->ws + WS_WATTN); }
    __device__ __forceinline__ bf16* WMIX() const { return (bf16*)(a->ws + WS_WMIX); }
    __device__ __forceinline__ bf16* WUG() const { return (bf16*)(a->ws + WS_WUG); }
    __device__ __forceinline__ bf16* WDOWN() const { return (bf16*)(a->ws + WS_WDOWN); }
    __device__ __forceinline__ bf16* XB() const { return (bf16*)(a->ws + WS_XB); }
    __device__ __forceinline__ bf16* CB() const { return (bf16*)(a->ws + WS_CB); }
    __device__ __forceinline__ bf16* CCH() const { return (bf16*)(a->ws + WS_CCH); }
    __device__ __forceinline__ bf16* QB() const { return (bf16*)(a->ws + WS_QB); }
    __device__ __forceinline__ bf16* KB() const { return (bf16*)(a->ws + WS_KB); }
    __device__ __forceinline__ bf16* VB() const { return (bf16*)(a->ws + WS_VB); }
    __device__ __forceinline__ bf16* IQB() const { return (bf16*)(a->ws + WS_IQB); }
    __device__ __forceinline__ bf16* IKB() const { return (bf16*)(a->ws + WS_IKB); }
    __device__ __forceinline__ bf16* SGA() const { return (bf16*)(a->ws + WS_SGA); }
    __device__ __forceinline__ bf16* SGB() const { return (bf16*)(a->ws + WS_SGB); }
    __device__ __forceinline__ bf16* A2() const { return (bf16*)(a->ws + WS_A2); }
    __device__ __forceinline__ bf16* MA() const { return (bf16*)(a->ws + WS_MA); }
    __device__ __forceinline__ bf16* OB() const { return (bf16*)(a->ws + WS_OB); }
    __device__ __forceinline__ bf16* MB() const { return (bf16*)(a->ws + WS_MB); }
    __device__ __forceinline__ bf16* X1B() const { return (bf16*)(a->ws + WS_X1B); }
    __device__ __forceinline__ bf16* UG() const { return (bf16*)(a->ws + WS_UG); }
    __device__ __forceinline__ bf16* HC() const { return (bf16*)(a->ws + WS_HC); }
    __device__ __forceinline__ float* IW() const { return (float*)(a->ws + WS_IW); }
    __device__ __forceinline__ bf16* PRE1B() const { return (bf16*)(a->ws + WS_PRE1); }
    __device__ __forceinline__ bf16* PRE2B() const { return (bf16*)(a->ws + WS_PRE2); }
    __device__ __forceinline__ f32x2* STATS() const { return (f32x2*)(a->ws + WS_STATS); }
    __device__ __forceinline__ float* ZS() const { return (float*)(a->ws + WS_ZS); }
    __device__ __forceinline__ float* YAS() const { return (float*)(a->ws + WS_YAS); }
    __device__ __forceinline__ float* SSC() const { return (float*)(a->ws + WS_SSC); }
    __device__ __forceinline__ f32x2* ROPEA() const { return (f32x2*)(a->ws + WS_ROPEA); }
    __device__ __forceinline__ f32x2* ROPEB() const { return (f32x2*)(a->ws + WS_ROPEB); }
    __device__ __forceinline__ unsigned long long* MASK() const { return (unsigned long long*)(a->ws + WS_MASK); }
    __device__ __forceinline__ const float* x_p() const { return (const float*)a->in[0]; }
    __device__ __forceinline__ const float* x_s() const { return (const float*)a->in[1]; }
    __device__ __forceinline__ const float* cache_k() const { return (const float*)a->in[2]; }
    __device__ __forceinline__ const float* cache_v() const { return (const float*)a->in[3]; }
    __device__ __forceinline__ const float* cache_ik() const { return (const float*)a->in[4]; }
    __device__ __forceinline__ const float* st_a() const { return (const float*)a->in[5]; }
    __device__ __forceinline__ const float* st_f() const { return (const float*)a->in[6]; }
    __device__ __forceinline__ const int* ptab() const { return (const int*)a->in[7]; }
    __device__ __forceinline__ const float* w_in() const { return (const float*)a->in[8]; }
    __device__ __forceinline__ const float* ikg() const { return (const float*)a->in[9]; }
    __device__ __forceinline__ const float* ikb() const { return (const float*)a->in[10]; }
    __device__ __forceinline__ const float* conv_a_w() const { return (const float*)a->in[11]; }
    __device__ __forceinline__ const float* w_a_out() const { return (const float*)a->in[12]; }
    __device__ __forceinline__ const float* w_attn_out() const { return (const float*)a->in[13]; }
    __device__ __forceinline__ const float* w_mix_out() const { return (const float*)a->in[14]; }
    __device__ __forceinline__ const float* ln1g() const { return (const float*)a->in[15]; }
    __device__ __forceinline__ const float* ln1b() const { return (const float*)a->in[16]; }
    __device__ __forceinline__ const float* w_up() const { return (const float*)a->in[17]; }
    __device__ __forceinline__ const float* w_gate() const { return (const float*)a->in[18]; }
    __device__ __forceinline__ const float* conv_f_w() const { return (const float*)a->in[19]; }
    __device__ __forceinline__ const float* conv_f_b() const { return (const float*)a->in[20]; }
    __device__ __forceinline__ const float* w_down() const { return (const float*)a->in[21]; }
    __device__ __forceinline__ const float* ln2g() const { return (const float*)a->in[22]; }
    __device__ __forceinline__ const float* ln2b() const { return (const float*)a->in[23]; }
    __device__ __forceinline__ float* out() const { return a->out; }
};

using pg8::Unit;
__device__ __forceinline__ v4u pk8v(f32x4 a, f32x4 b) { v4u w; w.x = pg8::cvt_pk_bf16(a[0], a[1]); w.y = pg8::cvt_pk_bf16(a[2], a[3]); w.z = pg8::cvt_pk_bf16(b[0], b[1]); w.w = pg8::cvt_pk_bf16(b[2], b[3]); return w; }
__device__ __forceinline__ f32x4 sig4(f32x4 a) { f32x4 r; r[0] = sigmoid_fast(a[0]); r[1] = sigmoid_fast(a[1]); r[2] = sigmoid_fast(a[2]); r[3] = sigmoid_fast(a[3]); return r; }
__device__ __forceinline__ f32x4 shfl4(f32x4 a, int m) { f32x4 r; r[0] = __shfl_xor(a[0], m); r[1] = __shfl_xor(a[1], m); r[2] = __shfl_xor(a[2], m); r[3] = __shfl_xor(a[3], m); return r; }
__device__ __forceinline__ void bf8_to_f(v4u w, f32x4& a, f32x4& b) { a[0] = bflo(w.x); a[1] = bfhi(w.x); a[2] = bflo(w.y); a[3] = bfhi(w.y); b[0] = bflo(w.z); b[1] = bfhi(w.z); b[2] = bflo(w.w); b[3] = bfhi(w.w); }

struct EpiZ {
    static constexpr bool PERM = true, AFTER_DRAIN = false;
    bf16 *CB, *CCH, *QB, *KB, *VB, *IQB, *SGA, *SGB; float *kout, *vout, *caout; const f32x2 *ropeA, *ropeB;
    __device__ __forceinline__ void operator()(const f32x4 (&acc)[2][2][4][2], const Unit& u, int wr, int wc, int fr, int fq) const {
        const int pn = u.pn, row0 = u.pm * 256 + wr * 64 + fr, lc = wc * 32 + 8 * fq;
        if (pn < 4) {
#pragma unroll
            for (int ai = 0; ai < 2; ++ai)
#pragma unroll
                for (int m = 0; m < 4; ++m) { const size_t row = row0 + ai * 128 + m * 16;
#pragma unroll
                    for (int bj = 0; bj < 2; ++bj) *(v4u*)(CB + row * DCONV + pn * 256 + bj * 128 + lc) = pk8v(acc[ai][bj][m][0], acc[ai][bj][m][1]); }
        } else if (pn < 12) {
            const int c0 = (pn - 4) * 128 + lc;
#pragma unroll
            for (int ai = 0; ai < 2; ++ai)
#pragma unroll
                for (int m = 0; m < 4; ++m) { const int row = row0 + ai * 128 + m * 16; const int t = row & (SEQ - 1);
                    const f32x4 p0 = acc[ai][0][m][0] * acc[ai][1][m][0], p1 = acc[ai][0][m][1] * acc[ai][1][m][1];
                    *(v4u*)(CCH + (size_t)row * DCONV + c0) = pk8v(p0, p1);
                    if (t >= SEQ - 2) { float* o = caout + ((size_t)((row >> 11) * 2 + (t - (SEQ - 2)))) * DCONV + c0; *(f32x4*)o = p0; *(f32x4*)(o + 4) = p1; } }
        } else if (pn < 22) {
            const bool isk = pn >= 20;
            const float sgn = fq < 2 ? -1.f : 1.f;
#pragma unroll
            for (int ai = 0; ai < 2; ++ai)
#pragma unroll
                for (int m = 0; m < 4; ++m) { const int row = row0 + ai * 128 + m * 16; const int t = row & (SEQ - 1);
                    f32x4 cs[4];
                    if (wc == 0) { const f32x4* rp = (const f32x4*)(ropeA + t * 16 + 8 * (fq & 1));
#pragma unroll
                        for (int e = 0; e < 4; ++e) cs[e] = rp[e]; }
#pragma unroll
                    for (int bj = 0; bj < 2; ++bj) { f32x4 v0 = acc[ai][bj][m][0], v1 = acc[ai][bj][m][1];
                        if (wc == 0) { const f32x4 o0 = shfl4(v0, 32), o1 = shfl4(v1, 32);
                            v0[0] = v0[0] * cs[0][0] + sgn * o0[0] * cs[0][1]; v0[1] = v0[1] * cs[0][2] + sgn * o0[1] * cs[0][3];
                            v0[2] = v0[2] * cs[1][0] + sgn * o0[2] * cs[1][1]; v0[3] = v0[3] * cs[1][2] + sgn * o0[3] * cs[1][3];
                            v1[0] = v1[0] * cs[2][0] + sgn * o1[0] * cs[2][1]; v1[1] = v1[1] * cs[2][2] + sgn * o1[1] * cs[2][3];
                            v1[2] = v1[2] * cs[3][0] + sgn * o1[2] * cs[3][1]; v1[3] = v1[3] * cs[3][2] + sgn * o1[3] * cs[3][3]; }
                        if (!isk) *(v4u*)(QB + (size_t)row * DQ + (pn - 12) * 256 + bj * 128 + lc) = pk8v(v0, v1);
                        else { const size_t o = (size_t)row * DKV + (pn - 20) * 256 + bj * 128 + lc; *(v4u*)(KB + o) = pk8v(v0, v1); __builtin_nontemporal_store(v0, (f32x4*)(kout + o)); __builtin_nontemporal_store(v1, (f32x4*)(kout + o + 4)); } } }
        } else if (pn < 24) {
#pragma unroll
            for (int ai = 0; ai < 2; ++ai)
#pragma unroll
                for (int m = 0; m < 4; ++m) { const size_t row = row0 + ai * 128 + m * 16;
#pragma unroll
                    for (int bj = 0; bj < 2; ++bj) { const size_t o = row * DKV + (pn - 22) * 256 + bj * 128 + lc; const f32x4 v0 = acc[ai][bj][m][0], v1 = acc[ai][bj][m][1];
                        *(v4u*)(VB + o) = pk8v(v0, v1); __builtin_nontemporal_store(v0, (f32x4*)(vout + o)); __builtin_nontemporal_store(v1, (f32x4*)(vout + o + 4)); } }
        } else if (pn < 28) {
            const bool rw = (wc & 1) == 0; const float sgn = fq == 0 ? -1.f : 1.f;
#pragma unroll
            for (int ai = 0; ai < 2; ++ai)
#pragma unroll
                for (int m = 0; m < 4; ++m) { const int row = row0 + ai * 128 + m * 16; const int t = row & (SEQ - 1);
                    f32x4 cs[4];
                    if (rw) { const f32x4* rp = (const f32x4*)(ropeB + t * 8);
#pragma unroll
                        for (int e = 0; e < 4; ++e) cs[e] = rp[e]; }
#pragma unroll
                    for (int bj = 0; bj < 2; ++bj) { f32x4 v0 = acc[ai][bj][m][0], v1 = acc[ai][bj][m][1];
                        if (rw) { const f32x4 o0 = shfl4(v0, 16), o1 = shfl4(v1, 16);
                            if (fq < 2) {
                            v0[0] = v0[0] * cs[0][0] + sgn * o0[0] * cs[0][1]; v0[1] = v0[1] * cs[0][2] + sgn * o0[1] * cs[0][3];
                            v0[2] = v0[2] * cs[1][0] + sgn * o0[2] * cs[1][1]; v0[3] = v0[3] * cs[1][2] + sgn * o0[3] * cs[1][3];
                            v1[0] = v1[0] * cs[2][0] + sgn * o1[0] * cs[2][1]; v1[1] = v1[1] * cs[2][2] + sgn * o1[1] * cs[2][3];
                            v1[2] = v1[2] * cs[3][0] + sgn * o1[2] * cs[3][1]; v1[3] = v1[3] * cs[3][2] + sgn * o1[3] * cs[3][3]; } }
                        *(v4u*)(IQB + (size_t)row * DIQ + (pn - 24) * 256 + bj * 128 + lc) = pk8v(v0, v1); } }
        } else {
            bf16* G_ = pn < 36 ? SGA : SGB; const int cb = (pn < 36 ? pn - 28 : pn - 36) * 256;
#pragma unroll
            for (int ai = 0; ai < 2; ++ai)
#pragma unroll
                for (int m = 0; m < 4; ++m) { const size_t row = row0 + ai * 128 + m * 16;
#pragma unroll
                    for (int bj = 0; bj < 2; ++bj) *(v4u*)(G_ + row * DM + cb + bj * 128 + lc) = pk8v(sig4(acc[ai][bj][m][0]), sig4(acc[ai][bj][m][1])); }
        }
    }
};
template <int MODE> struct EpiMerge {
    static constexpr bool PERM = true, AFTER_DRAIN = false;
    const bf16* SG; const bf16* MAin; bf16* O;
    __device__ __forceinline__ void operator()(const f32x4 (&acc)[2][2][4][2], const Unit& u, int wr, int wc, int fr, int fq) const {
        const int row0 = u.pm * 256 + wr * 64 + fr, col0 = u.pn * 256 + wc * 32 + 8 * fq;
#pragma unroll
        for (int ai = 0; ai < 2; ++ai)
#pragma unroll
            for (int m = 0; m < 4; ++m) { const size_t row = row0 + ai * 128 + m * 16;
#pragma unroll
                for (int bj = 0; bj < 2; ++bj) { const size_t o = row * DM + col0 + bj * 128; f32x4 g0, g1; bf8_to_f(*(const v4u*)(SG + o), g0, g1);
                    f32x4 r0 = g0 * acc[ai][bj][m][0], r1 = g1 * acc[ai][bj][m][1];
                    if (MODE == 1) { f32x4 a0, a1; bf8_to_f(*(const v4u*)(MAin + o), a0, a1); r0 += a0; r1 += a1; }
                    *(v4u*)(O + o) = pk8v(r0, r1); } }
    }
};
struct EpiPre1 {
    static constexpr bool PERM = true, AFTER_DRAIN = false;
    const float* X; bf16* O;
    __device__ __forceinline__ void operator()(const f32x4 (&acc)[2][2][4][2], const Unit& u, int wr, int wc, int fr, int fq) const {
        const int row0 = u.pm * 256 + wr * 64 + fr, col0 = u.pn * 256 + wc * 32 + 8 * fq;
#pragma unroll
        for (int ai = 0; ai < 2; ++ai)
#pragma unroll
            for (int m = 0; m < 4; ++m) { const size_t ro = (size_t)(row0 + ai * 128 + m * 16) * DM + col0;
#pragma unroll
                for (int bj = 0; bj < 2; ++bj) { const size_t o = ro + bj * 128; const f32x4 x0 = *(const f32x4*)(X + o), x1 = *(const f32x4*)(X + o + 4);
                    *(v4u*)(O + o) = pk8v(x0 * ALPHA + acc[ai][bj][m][0], x1 * ALPHA + acc[ai][bj][m][1]); } }
    }
};
struct EpiPre2 {
    static constexpr bool PERM = true, AFTER_DRAIN = false;
    const bf16* P1; const f32x2* ST; const float* G; const float* Bt_; bf16* O;
    __device__ __forceinline__ void operator()(const f32x4 (&acc)[2][2][4][2], const Unit& u, int wr, int wc, int fr, int fq) const {
        const int row0 = u.pm * 256 + wr * 64 + fr, col0 = u.pn * 256 + wc * 32 + 8 * fq;
        f32x4 gv[2][2], bv[2][2];
#pragma unroll
        for (int bj = 0; bj < 2; ++bj)
#pragma unroll
            for (int n = 0; n < 2; ++n) { gv[bj][n] = *(const f32x4*)(G + col0 + bj * 128 + 4 * n); bv[bj][n] = *(const f32x4*)(Bt_ + col0 + bj * 128 + 4 * n); }
#pragma unroll
        for (int ai = 0; ai < 2; ++ai)
#pragma unroll
            for (int m = 0; m < 4; ++m) { const int row = row0 + ai * 128 + m * 16; const f32x2 st = ST[row]; const size_t ro = (size_t)row * DM + col0;
#pragma unroll
                for (int bj = 0; bj < 2; ++bj) { const size_t o = ro + bj * 128; f32x4 p0, p1; bf8_to_f(*(const v4u*)(P1 + o), p0, p1);
                    const f32x4 x0 = (p0 - st.x) * st.y * gv[bj][0] + bv[bj][0], x1 = (p1 - st.x) * st.y * gv[bj][1] + bv[bj][1];
                    *(v4u*)(O + o) = pk8v(x0 * ALPHA + acc[ai][bj][m][0], x1 * ALPHA + acc[ai][bj][m][1]); } }
    }
};
__device__ __forceinline__ float dpp_shr1(float old, float x) { return __builtin_bit_cast(float, __builtin_amdgcn_update_dpp(__builtin_bit_cast(int, old), __builtin_bit_cast(int, x), 0x111, 0xf, 0xf, false)); }
__device__ __forceinline__ float dpp_shr2(float old, float x) { return __builtin_bit_cast(float, __builtin_amdgcn_update_dpp(__builtin_bit_cast(int, old), __builtin_bit_cast(int, x), 0x112, 0xf, 0xf, false)); }
__device__ __forceinline__ float dpp_ror1(float x) { return __builtin_bit_cast(float, __builtin_amdgcn_update_dpp(0, __builtin_bit_cast(int, x), 0x121, 0xf, 0xf, false)); }
__device__ __forceinline__ float dpp_ror2(float x) { return __builtin_bit_cast(float, __builtin_amdgcn_update_dpp(0, __builtin_bit_cast(int, x), 0x122, 0xf, 0xf, false)); }
__device__ __forceinline__ f32x2 gelu_tanh2(f32x2 x) {
    const f32x2 p = (x * x) * 0.10294324f + 2.3022082f; const f32x2 a = x * p;
    f32x2 e; e.x = __builtin_amdgcn_exp2f(a.x); e.y = __builtin_amdgcn_exp2f(a.y); e = e + 1.0f;
    f32x2 r; r.x = __builtin_amdgcn_rcpf(e.x); r.y = __builtin_amdgcn_rcpf(e.y);
    return x - x * r;
}
struct EpiHC {
    static constexpr bool PERM = true, AFTER_DRAIN = false;
    bf16* UG; bf16* HC; float* cfout; const float* cw; const float* cbias; LAS float* halo;
    __device__ __forceinline__ void operator()(const f32x4 (&acc)[2][2][4][2], const Unit& u, int wr, int wc, int fr, int fq) const {
        const int lc = wc * 32 + 8 * fq, f0 = u.pn * 128 + lc, row0 = u.pm * 256 + wr * 64 + fr;
        if (fr >= 14) {
#pragma unroll
            for (int ai = 0; ai < 2; ++ai) { LAS float* h = halo + (((2 * ai + wr) * 2 + (fr - 14)) * 128 + lc); *(LAS f32x4*)h = acc[ai][0][3][0]; *(LAS f32x4*)(h + 4) = acc[ai][0][3][1]; } }
        asm volatile("s_waitcnt lgkmcnt(0)" ::: "memory"); __builtin_amdgcn_s_barrier(); asm volatile("" ::: "memory");
        f32x2 w0[4], w1[4], w2[4], bb[4];
        {   const f32x2* p = (const f32x2*)(cw + f0); const f32x2* q = (const f32x2*)(cbias + f0);
#pragma unroll
            for (int k = 0; k < 4; ++k) { w0[k] = p[k]; w1[k] = p[DFF / 2 + k]; w2[k] = p[DFF + k]; bb[k] = q[k]; } }
        const bool seq0 = (u.pm & 7) == 0;
#pragma unroll
        for (int ai = 0; ai < 2; ++ai) {
            const int grp = 2 * ai + wr;
#pragma unroll
            for (int m = 0; m < 4; ++m) {
                const int row = row0 + ai * 128 + m * 16, t = row & (SEQ - 1), trow = 64 * grp + 16 * m + fr;
                float r[8];
#pragma unroll
                for (int e2 = 0; e2 < 4; ++e2) {
                    f32x2 x, gv, u1, u2;
#pragma unroll
                    for (int k = 0; k < 2; ++k) { const int e = 2 * e2 + k;
                        const float xe = acc[ai][0][m][e >> 2][e & 3];
                        float o1, o2;
                        if (m == 0) { float p15, p14; if (grp == 0) { p15 = 0.f; p14 = 0.f; } else { p15 = halo[((grp - 1) * 2 + 1) * 128 + lc + e]; p14 = halo[((grp - 1) * 2) * 128 + lc + e]; }
                            o1 = p15; o2 = fr == 1 ? p15 : p14; }
                        else { const float pvx = acc[ai][0][m > 0 ? m - 1 : 0][e >> 2][e & 3]; o1 = dpp_ror1(pvx); o2 = dpp_ror2(pvx); }
                        x[k] = xe; gv[k] = acc[ai][1][m][e >> 2][e & 3]; u1[k] = dpp_shr1(o1, xe); u2[k] = dpp_shr2(o2, xe); }
                    const f32x2 y = gelu_tanh2(w0[e2] * u2 + w1[e2] * u1 + w2[e2] * x + bb[e2]) * gv;
                    r[2 * e2] = y.x; r[2 * e2 + 1] = y.y;
                }
                if (trow >= 2 || seq0) *(v4u*)(HC + (size_t)row * DFF + f0) = pack8(r);
                if (trow < 2 || trow >= 254) { *(v4u*)(UG + (size_t)row * NUG + u.pn * 256 + lc) = pk8v(acc[ai][0][m][0], acc[ai][0][m][1]); if (trow < 2) *(v4u*)(UG + (size_t)row * NUG + u.pn * 256 + 128 + lc) = pk8v(acc[ai][1][m][0], acc[ai][1][m][1]); }
                if (t >= SEQ - 2) { float* o = cfout + ((size_t)((row >> 11) * 2 + (t - (SEQ - 2)))) * DFF + f0; *(f32x4*)o = acc[ai][0][m][0]; *(f32x4*)(o + 4) = acc[ai][0][m][1]; }
                asm volatile("" ::: "memory");
            }
        }
    }
};

template <int MT, int NTB, int NTW>
__device__ __forceinline__ void mini_gemm(const Frame& F, const bf16* A0, const bf16* B0, int K, int bvalid, f32x4 (&acc)[NTW]) {
    constexpr int R = (MT + NTB) * 16, PITCH = 272, BUF = R * PITCH, NP = (R * 16 + 511) / 512;
    static_assert(2 * BUF <= 100000, "mini_gemm LDS");
    const int fr = F.lane & 15, fq = F.lane >> 4, mt = F.wave % MT, ng = F.wave / MT;
    const bf16* src[NP]; int dst[NP];
#pragma unroll
    for (int i = 0; i < NP; ++i) { int p = F.tid + 512 * i; p = p < R * 16 ? p : R * 16 - 1;
        const int row = p >> 4, pc = p & 15; int br = row - MT * 16; br = br < bvalid ? br : bvalid - 1;
        src[i] = (row < MT * 16 ? A0 + (size_t)row * K : B0 + (size_t)br * K) + pc * 8; dst[i] = row * PITCH + pc * 16; }
    const int aoff = (mt * 16 + fr) * PITCH + fq * 16; int boff[NTW];
#pragma unroll
    for (int j = 0; j < NTW; ++j) { int tl = ng * NTW + j; tl = tl < NTB ? tl : NTB - 1; boff[j] = (MT * 16 + tl * 16 + fr) * PITCH + fq * 16; acc[j] = (f32x4){0.f, 0.f, 0.f, 0.f}; }
    const int nc = K >> 7;
    v4u st[4][NP];
#define MG_LOAD(slot, c) do { _Pragma("unroll") for (int i = 0; i < NP; ++i) st[slot][i] = *(const v4u*)(src[i] + (size_t)(c) * 128); } while (0)
#define MG_STEP(slot, c) do { if ((c) + 3 < nc) MG_LOAD(((slot) + 3) & 3, (c) + 3);                                                                                  \
        { LAS unsigned char* wb = F.lds + ((c) & 1) * BUF; _Pragma("unroll") for (int i = 0; i < NP; ++i) *(LAS v4u*)(wb + dst[i]) = st[slot][i]; }                   \
        asm volatile("s_waitcnt lgkmcnt(0)" ::: "memory"); __builtin_amdgcn_s_barrier(); asm volatile("" ::: "memory");                                              \
        { const LAS unsigned char* rb = F.lds + ((c) & 1) * BUF; _Pragma("unroll") for (int s = 0; s < 4; ++s) { const bf16x8 a = *(const LAS bf16x8*)(rb + aoff + s * 64); \
            _Pragma("unroll") for (int j = 0; j < NTW; ++j) acc[j] = __builtin_amdgcn_mfma_f32_16x16x32_bf16(*(const LAS bf16x8*)(rb + boff[j] + s * 64), a, acc[j], 0, 0, 0); } } } while (0)
    MG_LOAD(0, 0); MG_LOAD(1, 1); MG_LOAD(2, 2);
#pragma unroll 1
    for (int c = 0; c < nc; c += 4) { MG_STEP(0, c); MG_STEP(1, c + 1); MG_STEP(2, c + 2); MG_STEP(3, c + 3); }
    asm volatile("s_waitcnt lgkmcnt(0)" ::: "memory"); __builtin_amdgcn_s_barrier(); asm volatile("" ::: "memory");
#undef MG_LOAD
#undef MG_STEP
}
template <int NT, class E>
__device__ __forceinline__ void skinny_gemm(const Frame& F, const bf16* A, const bf16* Bt, int K, int ntn, const E& epi) {
    const int fr = F.lane & 15, fq = F.lane >> 4; const int nitems = (ntn + NT - 1) / NT;
    for (int it = blockIdx.x; it < nitems; it += F.G) {
        f32x4 acc[NT];
        mini_gemm<8, NT, NT>(F, A, Bt + (size_t)(it * NT * 16) * K, K, (ntn - it * NT) * 16, acc);
#pragma unroll
        for (int j = 0; j < NT; ++j) { const int tl = it * NT + j; if (tl < ntn) epi(16 * F.wave + fr, 16 * tl + 4 * fq, acc[j]); }
    }
}

template <class E>
__device__ __forceinline__ void skinny_gemm_half(const Frame& F, const bf16* A, const bf16* Bt, int K, int ntn, const E& epi) {
    const int fr = F.lane & 15, fq = F.lane >> 4;
    for (int it = blockIdx.x; it < 2 * ntn; it += F.G) {
        const int tl = it >> 1, rh = it & 1; f32x4 acc[1];
        mini_gemm<4, 1, 1>(F, A + (size_t)(rh * 64) * K, Bt + (size_t)(tl * 16) * K, K, 16, acc);
        if (F.wave < 4) epi(64 * rh + 16 * F.wave + fr, 16 * tl + 4 * fq, acc[0]);
    }
}

template <int MAP> __device__ __forceinline__ int phys_row(int l) {
    if (MAP == 0) return l;
    if (MAP == 1) {
        if (l < 1024) return l;
        if (l < 2048) { const int c = l - 1024; return 1024 + ((c >> 7) << 8) + (c & 127); }
        if (l < 3072) { const int c = l - 2048; return 1024 + ((c >> 7) << 8) + 128 + (c & 127); }
        if (l < 7168) return l;
        if (l < 7248) return NZ + (l - 7168);
        return l - 80; }
    if (MAP == 2) return ((l >> 7) << 8) + (l & 127);
    return ((l >> 7) << 8) + 128 + (l & 127);
}
template <int MAP> __device__ __forceinline__ void transpose_item(const float* W, int K, int N, bf16* WT, LAS float* scr, int item, int lane) {
    const int nblk = (N + 63) / 64, kb = item / nblk, nb = item % nblk, k0 = 64 * kb, n0 = 64 * nb;
    const int l16 = lane & 15, kq = lane >> 4, nn = n0 + 4 * l16;
    f32x4 v[16];
#pragma unroll
    for (int i = 0; i < 16; ++i) v[i] = nn < N ? __builtin_nontemporal_load((const f32x4*)(W + (size_t)(k0 + 4 * i + kq) * N + nn)) : (f32x4){0.f, 0.f, 0.f, 0.f};
#pragma unroll
    for (int i = 0; i < 16; ++i) { LAS float* s = scr + (4 * i + kq) * 65 + 4 * l16; s[0] = v[i][0]; s[1] = v[i][1]; s[2] = v[i][2]; s[3] = v[i][3]; }
    LDS_WAIT();
    const int c = lane & 7;
#pragma unroll
    for (int j = 0; j < 8; ++j) { const int n = (lane >> 3) + 8 * j; const LAS float* s = scr + (8 * c) * 65 + n;
        v4u o; o.x = pk2(s[0 * 65], s[1 * 65]); o.y = pk2(s[2 * 65], s[3 * 65]); o.z = pk2(s[4 * 65], s[5 * 65]); o.w = pk2(s[6 * 65], s[7 * 65]);
        if (n0 + n < N) *(v4u*)(WT + (size_t)phys_row<MAP>(n0 + n) * K + k0 + 8 * c) = o; }
    LDS_WAIT();
}
__device__ __forceinline__ void sincos_d(double a, float& c, float& s) {
    const double k = __builtin_rint(a * 0.63661977236758134308); const double y = (a - k * 1.57079632679489655800) - k * 6.12323399573676603587e-17; const double y2 = y * y;
    double sy = y * (1.0 + y2 * (-1.0 / 6 + y2 * (1.0 / 120 + y2 * (-1.0 / 5040 + y2 * (1.0 / 362880 + y2 * (-1.0 / 39916800 + y2 * (1.0 / 6227020800.0)))))));
    double cy = 1.0 + y2 * (-0.5 + y2 * (1.0 / 24 + y2 * (-1.0 / 720 + y2 * (1.0 / 40320 + y2 * (-1.0 / 3628800 + y2 * (1.0 / 479001600.0 + y2 * (-1.0 / 87178291200.0)))))));
    const int q = ((int)(long long)k) & 3;
    const double ss = (q & 1) ? cy : sy, cc = (q & 1) ? sy : cy;
    s = (float)((q & 2) ? -ss : ss); c = (float)(((q + 1) & 2) ? -cc : cc);
}
__device__ __forceinline__ void late_transposes(Frame& F) {
    LAS float* scr = (LAS float*)(F.lds + F.wave * 16640);
    int lane = F.lane; asm volatile("" : "+v"(lane));
    constexpr int I_AT = 32 * 32, I_MX = 32 * 32, I_UP = 32 * 88, I_GT = 32 * 88, I_DN = 88 * 32;
    constexpr int NITEMS = I_AT + I_MX + I_UP + I_GT + I_DN;
    for (int it = F.gw; it < NITEMS; it += F.NGW) {
        int r = it;
        if (r < I_AT) { transpose_item<0>(F.w_attn_out(), DQ, DM, F.WATTN(), scr, r, lane); continue; } r -= I_AT;
        if (r < I_MX) { transpose_item<0>(F.w_mix_out(), DM, DM, F.WMIX(), scr, r, lane); continue; } r -= I_MX;
        if (r < I_UP) { transpose_item<2>(F.w_up(), DM, DFF, F.WUG(), scr, r, lane); continue; } r -= I_UP;
        if (r < I_GT) { transpose_item<3>(F.w_gate(), DM, DFF, F.WUG(), scr, r, lane); continue; } r -= I_GT;
        transpose_item<0>(F.w_down(), DFF, DM, F.WDOWN(), scr, r, lane);
    }
}
__device__ __forceinline__ void p0_prologue(Frame& F) {
    LAS float* scr = (LAS float*)(F.lds + F.wave * 16640);
    constexpr int I_IN = 32 * 178, I_AO = 16 * 32;
    for (int it = F.gw; it < I_IN + I_AO; it += F.NGW) {
        if (it < I_IN) transpose_item<1>(F.w_in(), DM, DIN, F.WIN(), scr, it, F.lane);
        else transpose_item<0>(F.w_a_out(), DCONV, DM, F.WAOUT(), scr, it - I_IN, F.lane);
    }
    for (int m = F.gw; m < MALL; m += F.NGW) {
        const f32x4* xr = (const f32x4*)(m < MP ? F.x_p() + (size_t)m * DM : F.x_s() + (size_t)(m - MP) * DM) + 2 * F.lane;
        v4u* o = (v4u*)(F.XB() + (size_t)m * DM) + F.lane;
#pragma unroll
        for (int j = 0; j < 4; ++j) { const f32x4 a = __builtin_nontemporal_load(xr + 128 * j), b = __builtin_nontemporal_load(xr + 128 * j + 1); o[64 * j] = pk8v(a, b); }
    }
    const double fa[16] = {1.0, 0.44036660267178046, 0.19392274474868576, 0.08539710028576561, 0.03760603093086393, 0.016560440080994446, 0.007292664737217109, 0.003211445994752591,
                           0.001414213562373095, 0.000622772421914596, 0.0002742481756762073, 0.00012076973741146504, 5.318295896944988e-05, 2.341999896140934e-05, 1.031338537721246e-05, 4.5416704806078695e-06};
    for (int e = blockIdx.x * 512 + F.tid; e < (SEQ + DECS) * 24; e += F.G * 512) {
        const int pi = e / 24, j = e % 24; const double pos = pi < SEQ ? (double)pi : (double)(PAST + pi - SEQ);
        double fr_ = 1.0;
#pragma unroll
        for (int i = 0; i < 16; ++i) { const int want = j < 16 ? j : 2 * (j - 16); if (i == want) fr_ = fa[i]; }
        float c, s; sincos_d(pos * fr_, c, s);
        if (j < 16) F.ROPEA()[pi * 16 + j] = (f32x2){c, s}; else F.ROPEB()[pi * 8 + (j - 16)] = (f32x2){c, s};
    }
}

__device__ __forceinline__ void ikiw_phase(Frame& F) {
    LAS float* T = (LAS float*)(F.lds + 81920);
    const int fr = F.lane & 15, fq = F.lane >> 4, mt = F.wave & 3, ng = F.wave >> 2;
    for (int k = 0;; ++k) {
        int rb = blockIdx.x + k * F.G;
        if (F.G == 256 && k == 1) { if (blockIdx.x < 254) break; rb = blockIdx.x + 2; }
        if (rb >= MALL / 64) break;
        f32x4 acc[3];
        mini_gemm<4, 5, 3>(F, F.XB() + (size_t)(rb * 64) * DM, F.WIN() + (size_t)NZ * DM, DM, 80, acc);
#pragma unroll
        for (int j = 0; j < 3; ++j) { const int tl = ng * 3 + j; if (tl < 5) {
#pragma unroll
            for (int i = 0; i < 4; ++i) T[(mt * 16 + fr) * 81 + 16 * tl + 4 * fq + i] = acc[j][i]; } }
        __syncthreads();
        {   const int row = F.tid >> 3, g8 = F.tid & 7, grow = rb * 64 + row;
            float v[8]; float s = 0.f;
#pragma unroll
            for (int e = 0; e < 8; ++e) { v[e] = T[row * 81 + 8 * g8 + e]; s += v[e]; }
            s += __shfl_xor(s, 1); s += __shfl_xor(s, 2); s += __shfl_xor(s, 4);
            const float mean = s * (1.f / 64.f); float q = 0.f;
#pragma unroll
            for (int e = 0; e < 8; ++e) { v[e] -= mean; q += v[e] * v[e]; }
            q += __shfl_xor(q, 1); q += __shfl_xor(q, 2); q += __shfl_xor(q, 4);
            const float rstd = 1.0f / sqrtf(q * (1.f / 64.f) + LN_EPS);
            float y[8], o[8];
#pragma unroll
            for (int e = 0; e < 8; ++e) y[e] = v[e] * rstd * F.ikg()[8 * g8 + e] + F.ikb()[8 * g8 + e];
#pragma unroll
            for (int e = 0; e < 8; ++e) o[e] = __shfl_xor(y[e], 1);
            const f32x2* rp = F.ROPEB() + pos_index(grow) * 8;
            if (g8 < 2) { const float sgn = g8 == 0 ? -1.f : 1.f;
#pragma unroll
                for (int e = 0; e < 8; ++e) { const f32x2 cs = rp[e]; y[e] = y[e] * cs.x + sgn * o[e] * cs.y; } }
            *(v4u*)(F.IKB() + (size_t)grow * IDD + 8 * g8) = pack8(y);
            float* op = grow < MP ? F.out() + O_IKP + (size_t)grow * IDD + 8 * g8 : F.out() + O_IKS + (size_t)(grow - MP) * IDD + 8 * g8;
            *(f32x4*)op = (f32x4){y[0], y[1], y[2], y[3]}; *(f32x4*)(op + 4) = (f32x4){y[4], y[5], y[6], y[7]};
            if (g8 < 2) {
#pragma unroll
                for (int e = 0; e < 8; ++e) F.IW()[(size_t)grow * NIH + 8 * g8 + e] = T[row * 81 + 64 + 8 * g8 + e] * (0.25f * 0.125f); }
        }
        __syncthreads();
    }
}
struct EpiRawF32 { float* O; int ld; __device__ __forceinline__ void operator()(int r, int c, f32x4 v) const { *(f32x4*)(O + (size_t)r * ld + c) = v; } };

__device__ __forceinline__ void p2_pointwise(Frame& F) {
    const int gt = blockIdx.x * 512 + F.tid, NT_ = F.G * 512;
    for (int it = gt; it < MP * 128; it += NT_) {
        const int row = it >> 7, c0 = (it & 127) * 8, t = row & (SEQ - 1);
        float cb[8], u0[8], u1[8], u2[8], r[8];
        unpack8(*(const v4u*)(F.CB() + (size_t)row * DCONV + c0), cb);
        unpack8(*(const v4u*)(F.CCH() + (size_t)row * DCONV + c0), u2);
        if (t >= 1) unpack8(*(const v4u*)(F.CCH() + (size_t)(row - 1) * DCONV + c0), u1); else zero8(u1);
        if (t >= 2) unpack8(*(const v4u*)(F.CCH() + (size_t)(row - 2) * DCONV + c0), u0); else zero8(u0);
#pragma unroll
        for (int e = 0; e < 8; ++e) r[e] = cb[e] * (F.conv_a_w()[c0 + e] * u0[e] + F.conv_a_w()[DCONV + c0 + e] * u1[e] + F.conv_a_w()[2 * DCONV + c0 + e] * u2[e]);
        *(v4u*)(F.A2() + (size_t)row * DCONV + c0) = pack8(r);
    }
    const float* Z = F.ZS();
    for (int it = gt; it < MS * DCONV; it += NT_) {
        const int r = it >> 10, c = it & 1023, b = r >> 2, t = r & 3; const int pcc = 1024 + ((c >> 7) << 8) + (c & 127), pch = pcc + 128;
        float ext[3];
#pragma unroll
        for (int j = 0; j < 3; ++j) { const int i = t + j; ext[j] = i < 2 ? F.st_a()[(size_t)(b * 2 + i) * DCONV + c] : Z[(size_t)(4 * b + i - 2) * NZ + pcc] * Z[(size_t)(4 * b + i - 2) * NZ + pch]; }
        const float y = F.conv_a_w()[c] * ext[0] + F.conv_a_w()[DCONV + c] * ext[1] + F.conv_a_w()[2 * DCONV + c] * ext[2];
        F.A2()[(size_t)(MP + r) * DCONV + c] = (bf16)f2bf(Z[(size_t)r * NZ + c] * y);
        if (t >= 2) F.out()[O_CAS + (size_t)(b * 2 + (t - 2)) * DCONV + c] = ext[2];
    }
    for (int it = gt; it < MS * DQ; it += NT_) {
        const int r = it >> 11, col = it & 2047, d = col & 127, t = r & 3, p = 3072 + col; float v = Z[(size_t)r * NZ + p];
        if (d < 32) { const f32x2 cs = F.ROPEA()[(SEQ + t) * 16 + (d & 15)]; v = d < 16 ? v * cs.x - Z[(size_t)r * NZ + p + 16] * cs.y : v * cs.x + Z[(size_t)r * NZ + p - 16] * cs.y; }
        F.QB()[(size_t)(MP + r) * DQ + col] = (bf16)f2bf(v);
    }
    for (int it = gt; it < MS * DKV; it += NT_) {
        const int r = it >> 9, col = it & 511, d = col & 127, t = r & 3, p = 5120 + col; float v = Z[(size_t)r * NZ + p];
        if (d < 32) { const f32x2 cs = F.ROPEA()[(SEQ + t) * 16 + (d & 15)]; v = d < 16 ? v * cs.x - Z[(size_t)r * NZ + p + 16] * cs.y : v * cs.x + Z[(size_t)r * NZ + p - 16] * cs.y; }
        F.KB()[(size_t)(MP + r) * DKV + col] = (bf16)f2bf(v); F.out()[O_KS + (size_t)r * DKV + col] = v;
        const float vv = Z[(size_t)r * NZ + 5632 + col];
        F.VB()[(size_t)(MP + r) * DKV + col] = (bf16)f2bf(vv); F.out()[O_VS + (size_t)r * DKV + col] = vv;
    }
    for (int it = gt; it < MS * DIQ; it += NT_) {
        const int r = it >> 10, col = it & 1023, d = col & 63, t = r & 3, p = 6144 + col; float v = Z[(size_t)r * NZ + p];
        if (d < 16) { const f32x2 cs = F.ROPEB()[(SEQ + t) * 8 + (d & 7)]; v = d < 8 ? v * cs.x - Z[(size_t)r * NZ + p + 8] * cs.y : v * cs.x + Z[(size_t)r * NZ + p - 8] * cs.y; }
        F.IQB()[(size_t)(MP + r) * DIQ + col] = (bf16)f2bf(v);
    }
    for (int it = gt; it < MS * DM; it += NT_) {
        const int r = it >> 11, col = it & 2047;
        F.SGA()[(size_t)(MP + r) * DM + col] = (bf16)f2bf(sigmoidf_(Z[(size_t)r * NZ + 7168 + col]));
        F.SGB()[(size_t)(MP + r) * DM + col] = (bf16)f2bf(sigmoidf_(Z[(size_t)r * NZ + 9216 + col]));
    }
}

__device__ __forceinline__ float relu_i(float x) { const int i = __builtin_bit_cast(int, x); return __builtin_bit_cast(float, i > 0 ? i : 0); }
__device__ __forceinline__ int opaque_v(int v) { asm volatile("" : "+v"(v)); return v; }
__device__ __forceinline__ unsigned sortable(float f) { const unsigned b = __builtin_bit_cast(unsigned, f); return b ^ ((unsigned)((int)b >> 31) | 0x80000000u); }

__device__ __forceinline__ void sample_scores(Frame& F) {
    const int lane = F.lane, fr = lane & 15, fq = lane >> 4; const bool lo = lane < 32, b4 = (lane & 16) != 0;
    for (int it = blockIdx.x; it < DECB * 8; it += F.G) {
        const int b = it >> 3, c = it & 7;
        bf16x8 aq[4][2]; f32x4 wq[4];
#pragma unroll
        for (int t = 0; t < 4; ++t) { const bf16* qp = F.IQB() + (size_t)(MP + 4 * b + t) * DIQ + fr * IDD + 16 * fq; aq[t][0] = *(const bf16x8*)qp; aq[t][1] = *(const bf16x8*)(qp + 8);
            wq[t] = *(const f32x4*)(F.IW() + (size_t)(MP + 4 * b + t) * NIH + 4 * fq); }
        const int* pt = F.ptab() + b * NPAGES + c * 8; float* ssc = F.SSC() + (size_t)(4 * b + fq) * SSC_PITCH + c * 1024 + fr;
        f32x4 kv[2][4];
#define SS_LOAD(slot, kb) do { const int pg_ = pt[(kb) >> 3]; const f32x4* kp_ = (const f32x4*)(F.cache_ik() + ((size_t)pg_ * PAGE + ((kb) & 7) * 16 + fr) * IDD + 16 * fq); \
        _Pragma("unroll") for (int i_ = 0; i_ < 4; ++i_) kv[slot][i_] = kp_[i_]; } while (0)
#define SS_SCORE(b0_, b1_, out_) do { float p_[4]; _Pragma("unroll") for (int t = 0; t < 4; ++t) { \
            f32x4 acc_ = __builtin_amdgcn_mfma_f32_16x16x32_bf16(aq[t][0], b0_, (f32x4){0.f, 0.f, 0.f, 0.f}, 0, 0, 0); acc_ = __builtin_amdgcn_mfma_f32_16x16x32_bf16(aq[t][1], b1_, acc_, 0, 0, 0); \
            p_[t] = wq[t][0] * relu_i(acc_[0]) + wq[t][1] * relu_i(acc_[1]) + wq[t][2] * relu_i(acc_[2]) + wq[t][3] * relu_i(acc_[3]); } \
        const float r0_ = __shfl_xor(lo ? p_[2] : p_[0], 32), r1_ = __shfl_xor(lo ? p_[3] : p_[1], 32); const float a0_ = (lo ? p_[0] : p_[2]) + r0_, a1_ = (lo ? p_[1] : p_[3]) + r1_; \
        out_ = (b4 ? a1_ : a0_) + __shfl_xor(b4 ? a0_ : a1_, 16); } while (0)
        SS_LOAD(0, F.wave);
#pragma unroll
        for (int j = 0; j < 8; ++j) {
            const int kb = F.wave + 8 * j;
            if (j + 1 < 8) SS_LOAD((j + 1) & 1, kb + 8);
            bf16x8 b0, b1; { const v4u w0 = pk8v(kv[j & 1][0], kv[j & 1][1]), w1 = pk8v(kv[j & 1][2], kv[j & 1][3]); b0 = __builtin_bit_cast(bf16x8, w0); b1 = __builtin_bit_cast(bf16x8, w1); }
            float sc; SS_SCORE(b0, b1, sc);
            ssc[16 * kb] = sc;
        }
        if (c == 7 && F.wave == 0) {
            const bf16* kp = F.IKB() + (size_t)(MP + 4 * b + (fr < DECS ? fr : DECS - 1)) * IDD + 16 * fq;
            const bf16x8 b0 = *(const bf16x8*)kp, b1 = *(const bf16x8*)(kp + 8);
            float sc; SS_SCORE(b0, b1, sc);
            if (fr < DECS) F.SSC()[(size_t)(4 * b + fq) * SSC_PITCH + PAST + fr] = sc;
        }
#undef SS_LOAD
#undef SS_SCORE
    }
}
__device__ __forceinline__ void sample_attend(Frame& F) {
    LAS int* lst = (LAS int*)F.lds;
    LAS int* rid = (LAS int*)(F.lds + 1024);
    LAS float* qf = (LAS float*)(F.lds + 2048);
    LAS float* lg = (LAS float*)(F.lds + 2048 + 4096);
    LAS int* cnt = (LAS int*)(F.lds + 2048 + 4096 + 8192);
    LAS float* op = (LAS float*)(F.lds + 2048 + 4096 + 8192 + 128);
    const int lane = F.lane, kvl = F.wave >> 2, qt = F.wave & 3;
    for (int item = blockIdx.x; item < 2 * MS; item += F.G) {
        const int r = item >> 1, hp = item & 1, b = r >> 2, t = r & 3, kvh = 2 * hp + kvl;
        __syncthreads();
        {
            unsigned x[17]; const int ln = opaque_v(lane); const float* sp = F.SSC() + (size_t)r * SSC_PITCH + 1024 * F.wave + ln;
#pragma unroll
            for (int i = 0; i < 16; ++i) x[i] = sortable(sp[64 * i]);
            x[16] = (F.wave == 7 && ln <= t) ? sortable(F.SSC()[(size_t)r * SSC_PITCH + PAST + ln]) : 0u;
            unsigned tau = 0u;
            for (int bit = 31; bit >= 0; --bit) {
                const unsigned cand = tau | (1u << bit); int c = 0;
#pragma unroll
                for (int i = 0; i < 17; ++i) c += __popcll(__ballot(x[i] >= cand));
                LAS int* cb = cnt + (bit & 1) * 8;
                if (lane == 0) cb[F.wave] = c;
                __syncthreads();
                int tot = 0;
#pragma unroll
                for (int w = 0; w < 8; ++w) tot += cb[w];
                if (tot >= TOPK) tau = cand;
            }
            int cg = 0, ce = 0;
#pragma unroll
            for (int i = 0; i < 17; ++i) { cg += __popcll(__ballot(x[i] > tau)); ce += __popcll(__ballot(x[i] == tau)); }
            if (lane == 0) { cnt[16 + F.wave] = cg; cnt[24 + F.wave] = ce; }
            __syncthreads();
            int gtot = 0;
#pragma unroll
            for (int w = 0; w < 8; ++w) gtot += cnt[16 + w];
            const int need = TOPK - gtot;
            int base = 0, eqb = 0;
#pragma unroll
            for (int w = 0; w < 8; ++w) if (w < F.wave) { const int e_ = cnt[24 + w]; int k_ = need - eqb; k_ = k_ < 0 ? 0 : (k_ > e_ ? e_ : k_); base += cnt[16 + w] + k_; eqb += e_; }
            const unsigned long long lt = (1ull << ln) - 1ull;
#pragma unroll
            for (int i = 0; i < 17; ++i) {
                const bool gt = x[i] > tau, eq = x[i] == tau;
                const unsigned long long meq = __ballot(eq);
                const bool sel = gt || (eq && (eqb + __popcll(meq & lt)) < need);
                const unsigned long long ms = __ballot(sel);
                if (sel) lst[base + __popcll(ms & lt)] = i < 16 ? 1024 * F.wave + 64 * i + ln : PAST + ln;
                base += __popcll(ms); eqb += __popcll(meq);
            }
        }
        if (F.tid < 128) { const v4u* qp = (const v4u*)(F.QB() + (size_t)(MP + r) * DQ + hp * 8 * HD); float f[8]; unpack8(qp[F.tid], f);
#pragma unroll
            for (int e = 0; e < 8; ++e) qf[F.tid * 8 + e] = f[e]; }
        __syncthreads();
        if (F.tid < TOPK) { const int idx = lst[F.tid]; rid[F.tid] = idx < PAST ? F.ptab()[b * NPAGES + (idx >> 7)] * PAGE + (idx & 127) : -(idx - PAST) - 1; }
        __syncthreads();
        {
            float q0[4], q1[4];
#pragma unroll
            for (int g = 0; g < 4; ++g) { q0[g] = qf[(4 * kvl + g) * HD + 2 * lane]; q1[g] = qf[(4 * kvl + g) * HD + 2 * lane + 1]; }
            const float* ck = F.cache_k() + (size_t)kvh * HD + 2 * lane; const bf16* nk = F.KB() + (size_t)(MP + 4 * b) * DKV + kvh * HD + 2 * lane;
#pragma unroll 1
            for (int jb = 0; jb < 4; ++jb) {
                f32x2 kv[16];
#pragma unroll
                for (int u = 0; u < 16; ++u) { const int rr = rid[64 * qt + 16 * jb + u];
                    if (rr >= 0) kv[u] = *(const f32x2*)(ck + (size_t)rr * (NKV * HD)); else { const unsigned w = *(const unsigned*)(nk + (size_t)(-rr - 1) * DKV); kv[u] = (f32x2){bflo(w), bfhi(w)}; } }
#pragma unroll
                for (int u = 0; u < 16; ++u) {
                    float v[4];
#pragma unroll
                    for (int g = 0; g < 4; ++g) v[g] = q0[g] * kv[u].x + q1[g] * kv[u].y;
                    const bool lo = lane < 32;
                    const float r0 = __shfl_xor(lo ? v[2] : v[0], 32), r1 = __shfl_xor(lo ? v[3] : v[1], 32);
                    const float a0 = (lo ? v[0] : v[2]) + r0, a1 = (lo ? v[1] : v[3]) + r1;
                    const bool b4 = (lane & 16) != 0;
                    float c = (b4 ? a1 : a0) + __shfl_xor(b4 ? a0 : a1, 16);
                    c += __shfl_xor(c, 8); c += __shfl_xor(c, 4); c += __shfl_xor(c, 2); c += __shfl_xor(c, 1);
                    if ((lane & 15) == 0) lg[(4 * kvl + (lane >> 4)) * 256 + 64 * qt + 16 * jb + u] = c * 0.08838834764831845f;
                }
            }
        }
        __syncthreads();
        {
            LAS float* l = lg + F.wave * 256; float x4[4];
#pragma unroll
            for (int jj = 0; jj < 4; ++jj) x4[jj] = l[lane + 64 * jj];
            const float m = wave_max(fmaxf(fmaxf(x4[0], x4[1]), fmaxf(x4[2], x4[3]))); float s = 0.f;
#pragma unroll
            for (int jj = 0; jj < 4; ++jj) { x4[jj] = __expf(x4[jj] - m); s += x4[jj]; }
            const float inv = 1.0f / wave_sum(s);
#pragma unroll
            for (int jj = 0; jj < 4; ++jj) l[lane + 64 * jj] = x4[jj] * inv;
        }
        __syncthreads();
        {
            float o0[4] = {0.f, 0.f, 0.f, 0.f}, o1[4] = {0.f, 0.f, 0.f, 0.f};
            const float* cv = F.cache_v() + (size_t)kvh * HD + 2 * lane; const bf16* nv = F.VB() + (size_t)(MP + 4 * b) * DKV + kvh * HD + 2 * lane;
#pragma unroll 1
            for (int jb = 0; jb < 4; ++jb) {
                f32x2 vv[16];
#pragma unroll
                for (int u = 0; u < 16; ++u) { const int rr = rid[64 * qt + 16 * jb + u];
                    if (rr >= 0) vv[u] = *(const f32x2*)(cv + (size_t)rr * (NKV * HD)); else { const unsigned w = *(const unsigned*)(nv + (size_t)(-rr - 1) * DKV); vv[u] = (f32x2){bflo(w), bfhi(w)}; } }
#pragma unroll
                for (int u = 0; u < 16; ++u)
#pragma unroll
                    for (int g = 0; g < 4; ++g) { const float p = lg[(4 * kvl + g) * 256 + 64 * qt + 16 * jb + u]; o0[g] += p * vv[u].x; o1[g] += p * vv[u].y; }
            }
#pragma unroll
            for (int g = 0; g < 4; ++g) *(LAS f32x2*)(op + ((kvl * 4 + qt) * 4 + g) * HD + 2 * lane) = (f32x2){o0[g], o1[g]};
        }
        __syncthreads();
        {
            const int lh = F.tid >> 6, kl = lh >> 2, g = lh & 3; float s0 = 0.f, s1 = 0.f;
#pragma unroll
            for (int q = 0; q < 4; ++q) { const f32x2 v = *(const LAS f32x2*)(op + ((kl * 4 + q) * 4 + g) * HD + 2 * lane); s0 += v.x; s1 += v.y; }
            *((unsigned*)(F.OB() + (size_t)(MP + r) * DQ + (8 * hp + lh) * HD) + lane) = pk2(s0, s1);
        }
    }
}

template <bool FIRST> __device__ __forceinline__ void ln_rows(Frame& F, const bf16* in, bf16* outb, f32x2* stats, float* outf, const float* g, const float* bta) {
    for (int m = F.gw; m < MALL; m += F.NGW) {
        const v4u* xr = (const v4u*)(in + (size_t)m * DM) + F.lane;
        f32x4 v[8]; float s = 0.f;
#pragma unroll
        for (int j = 0; j < 4; ++j) bf8_to_f(xr[64 * j], v[2 * j], v[2 * j + 1]);
#pragma unroll
        for (int j = 0; j < 8; ++j) s += (v[j][0] + v[j][1]) + (v[j][2] + v[j][3]);
        const float mean = wave_sum(s) * (1.f / DM); float s2 = 0.f;
#pragma unroll
        for (int j = 0; j < 8; ++j) { v[j] = v[j] - mean; s2 += (v[j][0] * v[j][0] + v[j][1] * v[j][1]) + (v[j][2] * v[j][2] + v[j][3] * v[j][3]); }
        const float rstd = 1.0f / sqrtf(wave_sum(s2) * (1.f / DM) + LN_EPS);
        const f32x4* gp = (const f32x4*)g + 2 * F.lane; const f32x4* bp = (const f32x4*)bta + 2 * F.lane;
#pragma unroll
        for (int j = 0; j < 4; ++j) { const f32x4 y0 = v[2 * j] * rstd * gp[128 * j] + bp[128 * j], y1 = v[2 * j + 1] * rstd * gp[128 * j + 1] + bp[128 * j + 1];
            if (FIRST) ((v4u*)(outb + (size_t)m * DM) + F.lane)[64 * j] = pk8v(y0, y1);
            else { f32x4* of = (f32x4*)(outf + (size_t)m * DM) + 2 * F.lane; __builtin_nontemporal_store(y0, of + 128 * j); __builtin_nontemporal_store(y1, of + 128 * j + 1); } }
        if (FIRST && F.lane == 0) stats[m] = (f32x2){mean, rstd};
    }
}
__device__ __forceinline__ void hc_fix(Frame& F) {
    const int gt = blockIdx.x * 512 + F.tid, NT_ = F.G * 512;
    constexpr int NFIX = (MP / 256 - NBATCH) * 2;
    for (int it = gt; it < (NFIX + MS) * (DFF / 8); it += NT_) {
        const int ri = it / (DFF / 8), f0 = (it % (DFF / 8)) * 8; const int pc = ((f0 >> 7) << 8) + (f0 & 127);
        int row; if (ri < NFIX) { const int k = ri >> 1; row = ((k / 7) * 8 + 1 + k % 7) * 256 + (ri & 1); } else row = MP + (ri - NFIX);
        float u2[8], u1[8], u0[8], gg[8], r[8];
        unpack8(*(const v4u*)(F.UG() + (size_t)row * NUG + pc), u2);
        unpack8(*(const v4u*)(F.UG() + (size_t)row * NUG + pc + 128), gg);
        if (row < MP) { const int t = row & (SEQ - 1);
            if (t >= 1) unpack8(*(const v4u*)(F.UG() + (size_t)(row - 1) * NUG + pc), u1); else {
#pragma unroll
                for (int e = 0; e < 8; ++e) u1[e] = 0.f; }
            if (t >= 2) unpack8(*(const v4u*)(F.UG() + (size_t)(row - 2) * NUG + pc), u0); else {
#pragma unroll
                for (int e = 0; e < 8; ++e) u0[e] = 0.f; }
        } else { const int r_ = row - MP, b = r_ >> 2, t = r_ & 3;
            if (t >= 1) unpack8(*(const v4u*)(F.UG() + (size_t)(row - 1) * NUG + pc), u1); else {
#pragma unroll
                for (int e = 0; e < 8; ++e) u1[e] = F.st_f()[(size_t)(b * 2 + 1) * DFF + f0 + e]; }
            if (t >= 2) unpack8(*(const v4u*)(F.UG() + (size_t)(row - 2) * NUG + pc), u0); else {
#pragma unroll
                for (int e = 0; e < 8; ++e) u0[e] = F.st_f()[(size_t)(b * 2 + t) * DFF + f0 + e]; }
        }
#pragma unroll
        for (int e = 0; e < 8; ++e) { const float cv = F.conv_f_w()[f0 + e] * u0[e] + F.conv_f_w()[DFF + f0 + e] * u1[e] + F.conv_f_w()[2 * DFF + f0 + e] * u2[e] + F.conv_f_b()[f0 + e]; r[e] = gelu_tanh(cv) * gg[e]; }
        *(v4u*)(F.HC() + (size_t)row * DFF + f0) = pack8(r);
    }
}

namespace att {
constexpr int D = 128, QSTR = 2048, KSTR = 512;
constexpr float THR = 8.f; constexpr bool WSKIP = false; constexpr int WINDOW = 1 << 30;
constexpr float SCALE = 0.08838834764831845f;
constexpr int NW = 8, QBLK = 32, KVBLK = 64, QB = NW * QBLK;
constexpr int SHM_V = KVBLK * D * 2, SHM_K = KVBLK * D * 2;
constexpr int ATT_LDS_BYTES = 2 * SHM_V + 2 * SHM_K + NW * 64 * 4;

typedef unsigned short bf16;
typedef short bf16x8 __attribute__((ext_vector_type(8)));
typedef short s16x4 __attribute__((ext_vector_type(4)));
typedef float f32x16 __attribute__((ext_vector_type(16)));
typedef float f32x4 __attribute__((ext_vector_type(4)));
typedef unsigned u32x4 __attribute__((ext_vector_type(4)));
template <class A, class Bt> struct same_t { static constexpr bool v = false; };
template <class A> struct same_t<A, A> { static constexpr bool v = true; };

#define KSWZ(row, colB) ((row) * 256 + ((colB) ^ (((row) & 7) << 4)))
#define SBAR() __builtin_amdgcn_sched_barrier(0)
__device__ __forceinline__ int v_st(int k, int c) { const int kk = (k & ~0xC) | ((k & 4) << 1) | ((k & 8) >> 1); return ((kk >> 3) * 4 + (c >> 5)) * 512 + ((kk & 7) * 32 + (c & 31)) * 2; }
__device__ __forceinline__ int v_rd_base(int lane) { return ((lane & 3) << 3) | (((lane >> 2) & 3) << 6) | (((lane >> 4) & 1) << 5) | (((lane >> 5) & 1) << 8); }
constexpr int v_rd_off(int d0, int ks, int half) { return d0 * 512 + ks * 4096 + half * 2048; }
__device__ __forceinline__ int crow(int r, int hi) { return (r & 3) + 8 * (r >> 2) + 4 * hi; }
__device__ __forceinline__ unsigned cvtpk(float lo, float hi) { return pg8::cvt_pk_bf16(lo, hi); }
__device__ __forceinline__ bf16x8 pack8(f32x4 a, f32x4 b) {
    u32x4 w = {cvtpk(a[0], a[1]), cvtpk(a[2], a[3]), cvtpk(b[0], b[1]), cvtpk(b[2], b[3])};
    return *reinterpret_cast<bf16x8*>(&w);
}
template <class T> __device__ __forceinline__ bf16x8 load8(const T* p) {
    if constexpr (same_t<T, float>::v) { return pack8(*(const f32x4*)p, *(const f32x4*)(p + 4)); }
    else { return *reinterpret_cast<const bf16x8*>(p); }
}
__device__ __forceinline__ void mask_tile(f32x16& p0, f32x16& p1, int dq, unsigned W) {
    const float NEG = -__builtin_inff();
#pragma unroll
    for (int r = 0; r < 16; ++r) {
        const int c = (r & 3) + 8 * (r >> 2);
        if ((unsigned)(dq - c) >= W) p0[r] = NEG;
        if ((unsigned)(dq - c - 32) >= W) p1[r] = NEG;
    }
}
__device__ __forceinline__ void mask_bits(f32x16& p0, f32x16& p1, unsigned long long mw, int hi) {
    const float NEG = -__builtin_inff();
    const unsigned w0 = (unsigned)mw >> (4 * hi), w1 = (unsigned)(mw >> 32) >> (4 * hi);
#pragma unroll
    for (int r = 0; r < 16; ++r) {
        const int c = (r & 3) + 8 * (r >> 2);
        if (((w0 >> c) & 1u) == 0u) p0[r] = NEG;
        if (((w1 >> c) & 1u) == 0u) p1[r] = NEG;
    }
}
__device__ __forceinline__ void partialSM(f32x16& p0, f32x16& p1, float& m_reg, float& mn, float& alpha) {
    float pmax = p0[0]; for (int r = 1; r < 16; ++r) pmax = fmaxf(pmax, p0[r]); for (int r = 0; r < 16; ++r) pmax = fmaxf(pmax, p1[r]);
    { auto rr = __builtin_amdgcn_permlane32_swap(__float_as_uint(pmax), __float_as_uint(pmax), false, false);
      pmax = fmaxf(__uint_as_float(rr[0]), __uint_as_float(rr[1])); }
    constexpr float C2 = 1.4426950408889634f * SCALE;
    if (__builtin_expect(__all((pmax - m_reg) * SCALE <= THR), 1)) { mn = m_reg; alpha = 1.f; }
    else { mn = fmaxf(m_reg, pmax); alpha = __builtin_amdgcn_exp2f((m_reg - mn) * C2); m_reg = mn; }
    const float mnL = -mn * C2;
    for (int r = 0; r < 16; ++r) p0[r] = fmaf(p0[r], C2, mnL); for (int r = 0; r < 16; ++r) p1[r] = fmaf(p1[r], C2, mnL);
    for (int r = 0; r < 16; ++r) p0[r] = __builtin_amdgcn_exp2f(p0[r]);
}
__device__ __forceinline__ void finishSM(f32x16& p0, f32x16& p1, float alpha, float& l_reg, bf16x8& pa0, bf16x8& pa1, bf16x8& pa2, bf16x8& pa3) {
    for (int r = 0; r < 16; ++r) p1[r] = __builtin_amdgcn_exp2f(p1[r]);
    float ps = 0; for (int r = 0; r < 16; ++r) ps += p0[r]; for (int r = 0; r < 16; ++r) ps += p1[r];
    { auto rr = __builtin_amdgcn_permlane32_swap(__float_as_uint(ps), __float_as_uint(ps), false, false);
      ps = __uint_as_float(rr[0]) + __uint_as_float(rr[1]); }
    l_reg = l_reg * alpha + ps;
#define PK4(P, B_, OUT) do { unsigned a0 = cvtpk(P[B_+0], P[B_+1]), a1 = cvtpk(P[B_+2], P[B_+3]);                          \
        unsigned b0 = cvtpk(P[B_+4], P[B_+5]), b1 = cvtpk(P[B_+6], P[B_+7]);                                             \
        auto r0 = __builtin_amdgcn_permlane32_swap(a0, b0, false, false); auto r1 = __builtin_amdgcn_permlane32_swap(a1, b1, false, false); \
        u32x4 w = {r0[0], r1[0], r0[1], r1[1]}; OUT = *reinterpret_cast<bf16x8*>(&w); } while (0)
    PK4(p0, 0, pa0); PK4(p0, 8, pa1); PK4(p1, 0, pa2); PK4(p1, 8, pa3);
#undef PK4
}
template <int KB, bool SK>
__device__ __forceinline__ void qkt(f32x16& p0, f32x16& p1, const char* K_lds, int r32, int hi, const bf16x8* qr, bool act) {
    if (SK && !act) { const float NEG = -__builtin_inff();
#pragma unroll
        for (int r = 0; r < 16; ++r) { p0[r] = NEG; p1[r] = NEG; } return; }
    p0 = f32x16{}; p1 = f32x16{};
    const char* kb[4];
#pragma unroll
    for (int dd = 0; dd < 4; ++dd) kb[dd] = K_lds + KB * SHM_K + KSWZ(r32, (dd * 16 + hi * 8) * 2);
#pragma unroll
    for (int d0 = 0; d0 < 8; ++d0) { const char* a = kb[d0 & 3] + (d0 >> 2) * 128;
        bf16x8 b0 = *reinterpret_cast<const bf16x8*>(a);
        bf16x8 b1 = *reinterpret_cast<const bf16x8*>(a + 32 * 256);
        p0 = __builtin_amdgcn_mfma_f32_32x32x16_bf16(b0, qr[d0], p0, 0, 0, 0);
        p1 = __builtin_amdgcn_mfma_f32_32x32x16_bf16(b1, qr[d0], p1, 0, 0, 0); }
}
template <int VB, bool SK>
__device__ __forceinline__ void pv_tile(f32x16* o, int vb0, bf16x8 pa0, bf16x8 pa1, bf16x8 pa2, bf16x8 pa3, bool act) {
    if (SK && !act) return;
#define TRRD(dst, off) asm volatile("ds_read_b64_tr_b16 %0, %1 offset:%2" : "=&v"(dst) : "v"(vb0), "i"(off) : "memory")
#define PV_D0(d0) do { s16x4 l0, l1, l2, l3, h0, h1, h2, h3; constexpr int b_ = VB * SHM_V + v_rd_off(d0, 0, 0);     \
        TRRD(l0, b_); TRRD(h0, b_ + 2048); TRRD(l1, b_ + 4096); TRRD(h1, b_ + 6144); TRRD(l2, b_ + 8192); TRRD(h2, b_ + 10240); TRRD(l3, b_ + 12288); TRRD(h3, b_ + 14336); \
        asm volatile("s_waitcnt lgkmcnt(0)" ::: "memory"); SBAR();                 \
        o[d0] = __builtin_amdgcn_mfma_f32_32x32x16_bf16(pa0, (bf16x8){l0[0], l0[1], l0[2], l0[3], h0[0], h0[1], h0[2], h0[3]}, o[d0], 0, 0, 0);   \
        o[d0] = __builtin_amdgcn_mfma_f32_32x32x16_bf16(pa1, (bf16x8){l1[0], l1[1], l1[2], l1[3], h1[0], h1[1], h1[2], h1[3]}, o[d0], 0, 0, 0);   \
        o[d0] = __builtin_amdgcn_mfma_f32_32x32x16_bf16(pa2, (bf16x8){l2[0], l2[1], l2[2], l2[3], h2[0], h2[1], h2[2], h2[3]}, o[d0], 0, 0, 0);   \
        o[d0] = __builtin_amdgcn_mfma_f32_32x32x16_bf16(pa3, (bf16x8){l3[0], l3[1], l3[2], l3[3], h3[0], h3[1], h3[2], h3[3]}, o[d0], 0, 0, 0); } while (0)
    PV_D0(0); PV_D0(1); PV_D0(2); PV_D0(3);
#undef PV_D0
#undef TRRD
}

template <class TIn, class TOut> struct BlockRef { const TIn* Q; const TIn* K; const TIn* V; TOut* O; const unsigned long long* MW; int P0; };
template <class TIn> struct Seam {
    bf16x8 qr[8];
    bf16x8 st_v0, st_v1, st_k0, st_k1; f32x4 sf0, sf1, sf2, sf3;
    f32x4 tq[16];
};
__device__ __forceinline__ int swa_jlo(int P0, int W) { const int lowk = P0 - W + 1; return lowk > 0 ? lowk / KVBLK : 0; }
#define ROW(p, k0, rr) ((p) + (unsigned)(((k0) + (rr)) * KSTR + sc))
#define VMW() asm volatile("s_waitcnt vmcnt(0)" ::: "memory")
#define VMWN(n) asm volatile("s_waitcnt vmcnt(%0)" :: "i"(n) : "memory")
#define SLOAD_H(Kp, Vp, k0) do { S.st_v0 = load8<TIn>(ROW(Vp, k0, sr)); S.st_v1 = load8<TIn>(ROW(Vp, k0, 32 + sr));              \
                         S.st_k0 = load8<TIn>(ROW(Kp, k0, sr)); S.st_k1 = load8<TIn>(ROW(Kp, k0, 32 + sr)); } while (0)
#define SWRITE_HK(bf) do { *(bf16x8*)(K_lds + (bf) * SHM_K + kws) = S.st_k0; *(bf16x8*)(K_lds + (bf) * SHM_K + kws + 32 * 256) = S.st_k1; } while (0)
#define SWRITE_HV(bf) do { *(bf16x8*)(V_lds + (bf) * SHM_V + vst0) = S.st_v0; *(bf16x8*)(V_lds + (bf) * SHM_V + vst1) = S.st_v1; } while (0)
#define SWRITE_H(bf) do { SWRITE_HV(bf); SWRITE_HK(bf); } while (0)
#define SLOAD_F(p, k0) do { S.sf0 = *(const f32x4*)ROW(p, k0, sr); S.sf1 = *(const f32x4*)(ROW(p, k0, sr) + 4);                \
                            S.sf2 = *(const f32x4*)ROW(p, k0, 32 + sr); S.sf3 = *(const f32x4*)(ROW(p, k0, 32 + sr) + 4); } while (0)
#define SWRITE_KF(bf) do { *(bf16x8*)(K_lds + (bf) * SHM_K + kws) = pack8(S.sf0, S.sf1); *(bf16x8*)(K_lds + (bf) * SHM_K + kws + 32 * 256) = pack8(S.sf2, S.sf3); } while (0)
#define SWRITE_VF(bf) do { *(bf16x8*)(V_lds + (bf) * SHM_V + vst0) = pack8(S.sf0, S.sf1); *(bf16x8*)(V_lds + (bf) * SHM_V + vst1) = pack8(S.sf2, S.sf3); } while (0)
template <class TIn, class TOut>
__device__ __forceinline__ void causal_swa_prime(const BlockRef<TIn, TOut>& cur, int W, char* lds, Seam<TIn>& S) {
    constexpr bool F32 = same_t<TIn, float>::v;
    const int tid = threadIdx.x, wid = __builtin_amdgcn_readfirstlane(tid >> 6), lane = tid & 63, r32 = lane & 31, hi = lane >> 5;
    const int sr = tid >> 4, sc = (tid & 15) * 8, kws = KSWZ(sr, sc * 2); char* K_lds = lds + 2 * SHM_V;
    const int kb0 = swa_jlo(cur.P0, W) * KVBLK;
    for (int d0 = 0; d0 < 8; ++d0) S.qr[d0] = load8<TIn>(cur.Q + (unsigned)((wid * QBLK + r32) * QSTR + d0 * 16 + hi * 8));
    if constexpr (F32) { SLOAD_F((const float*)cur.K, kb0); VMW(); SWRITE_KF(0); SBAR(); SLOAD_F((const float*)cur.V, kb0); }
    else { SLOAD_H(cur.K, cur.V, kb0); VMW(); SWRITE_HK(0); }
    __syncthreads();
}
template <class TIn, class TOut>
__device__ __forceinline__ void causal_swa_block(const BlockRef<TIn, TOut>& cur, const BlockRef<TIn, TOut>& nxt, int skv, int W, char* lds, Seam<TIn>& S) {
    constexpr bool F32 = same_t<TIn, float>::v;
    const int tid = threadIdx.x, wid = __builtin_amdgcn_readfirstlane(tid >> 6), lane = tid & 63, r32 = lane & 31, hi = lane >> 5;
    const int j_lo = swa_jlo(cur.P0, W);
    int j_hi = (cur.P0 + QB - 1) / KVBLK + 1; if (j_hi > skv / KVBLK) j_hi = skv / KVBLK;
    const int NT = j_hi - j_lo;
    const int kbn = swa_jlo(nxt.P0, W) * KVBLK;
    const int qlo = cur.P0 + wid * QBLK, qm = qlo + r32 - 4 * hi;
    char* V_lds = lds; char* K_lds = lds + 2 * SHM_V;
    float* ws = (float*)(lds + 2 * SHM_V + 2 * SHM_K) + wid * 64; float* li_l = ws, * al_l = ws + 32;
    float m_reg = -1e30f, l_reg = 0; f32x16 o[4] = {};
    const int sr = tid >> 4, sc = (tid & 15) * 8, vst0 = v_st(sr, sc), vst1 = v_st(32 + sr, sc), kws = KSWZ(sr, sc * 2);
    const int vb0 = (int)(uintptr_t)V_lds + v_rd_base(lane);
    const TIn* Kh = cur.K; const TIn* Vh = cur.V;
#define RESC(a) do { if (__any((a) < 1.f)) { if (hi == 0) al_l[r32] = (a); asm volatile("s_waitcnt lgkmcnt(0)" ::: "memory");              \
                     for (int d_ = 0; d_ < 4; ++d_) for (int r = 0; r < 16; ++r) o[d_][r] *= al_l[crow(r, hi)]; } } while (0)
#define KBASE(t) ((j_lo + (t)) * KVBLK)
#define ACT(t) (KBASE(t) <= qlo + QBLK - 1 && KBASE(t) + KVBLK - 1 >= qlo - W + 1)
#define MASKT(P0_, P1_, MW_) mask_bits(P0_, P1_, MW_, hi)
#define MWLOAD(t) (*(const unsigned long long*)(mlane + 8 * (j_lo + (t))))
    constexpr int NQL = F32 ? 16 : 8;
    constexpr bool SK = WSKIP && !F32;
#define SEAM_K0() do { VMWN(NQL); if constexpr (F32) { SWRITE_KF(0); SBAR(); SLOAD_F((const float*)nxt.V, kbn); } else { SWRITE_HK(0); } SBAR(); } while (0)
    f32x16 pA0, pA1, pB0, pB1; float mnA, mnB, alA, alB; bf16x8 pa0, pa1, pa2, pa3;
    char* M_lds = lds + ATT_LDS_BYTES + wid * 8192; const char* mlane = M_lds + r32 * 256; unsigned long long mwA, mwB; u32x4 mtmp[8];
    const u32x4* mg = (const u32x4*)(cur.MW + (size_t)(wid * QBLK) * 32) + lane;
    if constexpr (F32) { VMW(); SWRITE_VF(0); SBAR(); } else { SWRITE_HV(0); SBAR(); }
    if (NT > 1) { if constexpr (F32) SLOAD_F((const float*)Kh, KBASE(1)); else SLOAD_H(Kh, Vh, KBASE(1)); }
#pragma unroll
    for (int i = 0; i < 8; ++i) mtmp[i] = mg[64 * i];
    SBAR(); qkt<0, SK>(pA0, pA1, K_lds, r32, hi, S.qr, ACT(0));
    if constexpr (F32) { if (NT > 1) { VMW(); SWRITE_KF(1); SBAR(); SLOAD_F((const float*)Vh, KBASE(1)); } }
#pragma unroll
    for (int i = 0; i < 8; ++i) *((u32x4*)M_lds + lane + 64 * i) = mtmp[i];
    SBAR(); mwA = MWLOAD(0);
    MASKT(pA0, pA1, mwA); partialSM(pA0, pA1, m_reg, mnA, alA);
    if (NT > 1) { VMW(); if constexpr (F32) { SWRITE_VF(1); SBAR(); if (NT > 2) SLOAD_F((const float*)Kh, KBASE(2)); } else SWRITE_H(1); }
    __syncthreads();
#define HALF_STEP(PX0, PX1, mnX, alX, PY0, PY1, alY, t, KB, VB, SB, MWX) do {                                                 \
        SBAR(); qkt<KB, SK>(PX0, PX1, K_lds, r32, hi, S.qr, ACT(t));                                             \
        finishSM(PY0, PY1, alY, l_reg, pa0, pa1, pa2, pa3); SBAR();                                                           \
        if ((t) + 1 < NT) { if constexpr (F32) { VMW(); SWRITE_KF(SB); SBAR(); SLOAD_F((const float*)Vh, KBASE((t) + 1)); }  \
                            else { SLOAD_H(Kh, Vh, KBASE((t) + 1)); } SBAR(); }                                               \
        MWX = MWLOAD(t); pv_tile<VB, SK>(o, vb0, pa0, pa1, pa2, pa3, ACT((t) - 1)); MASKT(PX0, PX1, MWX); partialSM(PX0, PX1, m_reg, mnX, alX);                                        \
        __syncthreads();                                                                                                      \
        if ((t) + 1 < NT) { VMW(); if constexpr (F32) { SWRITE_VF(SB); SBAR(); if ((t) + 2 < NT) SLOAD_F((const float*)Kh, KBASE((t) + 2)); } \
                            else { SWRITE_H(SB); } }                                                                          \
        RESC(alX); __syncthreads(); } while (0)
    for (int t = 1; t + 1 < NT; t += 2) {
        HALF_STEP(pB0, pB1, mnB, alB, pA0, pA1, alA, t, 1, 0, 0, mwB);
        HALF_STEP(pA0, pA1, mnA, alA, pB0, pB1, alB, t + 1, 0, 1, 1, mwA);
    }
    const bool even = (NT & 1) == 0;
    if (even) { SBAR(); qkt<1, SK>(pB0, pB1, K_lds, r32, hi, S.qr, ACT(NT - 1)); SBAR(); }
#define QROW(e) (nxt.Q + (size_t)(wid * QBLK + r32) * QSTR + ((e) >> 1) * 16 + hi * 8 + ((e) & 1) * 4)
    if constexpr (F32) { SLOAD_F((const float*)nxt.K, kbn); SBAR();
#pragma unroll
        for (int e = 0; e < 8; ++e) S.tq[e] = *(const f32x4*)QROW(e); }
    else { SLOAD_H(nxt.K, nxt.V, kbn); SBAR();
#pragma unroll
        for (int d0 = 0; d0 < 8; ++d0) S.qr[d0] = load8<TIn>(nxt.Q + (unsigned)((wid * QBLK + r32) * QSTR + d0 * 16 + hi * 8)); }
    SBAR();
    finishSM(pA0, pA1, alA, l_reg, pa0, pa1, pa2, pa3); SBAR();
    if constexpr (F32) {
#pragma unroll
        for (int e = 8; e < 16; ++e) S.tq[e] = *(const f32x4*)QROW(e); SBAR(); }
#undef QROW
    pv_tile<0, SK>(o, vb0, pa0, pa1, pa2, pa3, ACT(even ? NT - 2 : NT - 1));
    if (even) { mwB = MWLOAD(NT - 1); MASKT(pB0, pB1, mwB); partialSM(pB0, pB1, m_reg, mnB, alB); __syncthreads(); RESC(alB);
        finishSM(pB0, pB1, alB, l_reg, pa0, pa1, pa2, pa3); SBAR(); pv_tile<1, SK>(o, vb0, pa0, pa1, pa2, pa3, ACT(NT - 1)); }
    SBAR(); SEAM_K0();
    if (hi == 0) li_l[r32] = l_reg; asm volatile("s_waitcnt lgkmcnt(0)" ::: "memory");
    int r32e = r32, hie = hi; asm volatile("" : "+v"(r32e), "+v"(hie));
    float rli[16];
#pragma unroll
    for (int r = 0; r < 16; ++r) rli[r] = __builtin_amdgcn_rcpf(li_l[crow(r, hie)]);
    TOut* Ow = cur.O + (size_t)(wid * QBLK) * QSTR;
#pragma unroll
    for (int r = 0; r < 16; ++r) { const int orow = crow(r, hie);
#pragma unroll
        for (int d0 = 0; d0 < 4; ++d0) { const float v = o[d0][r] * rli[r];
            if constexpr (same_t<TOut, float>::v) { Ow[(unsigned)(orow * QSTR + d0 * 32 + r32e)] = v; }
            else { const float vn = __shfl_xor(v, 1);
                   if ((r32e & 1) == 0) *(unsigned*)(Ow + (unsigned)(orow * QSTR + d0 * 32 + r32e)) = cvtpk(v, vn); } } }
    if constexpr (F32) {
#pragma unroll
        for (int d0 = 0; d0 < 8; ++d0) S.qr[d0] = pack8(S.tq[2 * d0], S.tq[2 * d0 + 1]); }
    __syncthreads();
#undef RESC
#undef KBASE
#undef ACT
#undef MASKT
#undef MWLOAD
#undef SEAM_K0
#undef HALF_STEP
}
#undef ROW
#undef VMW
#undef VMWN
#undef SLOAD_H
#undef SWRITE_HK
#undef SWRITE_HV
#undef SWRITE_H
#undef SLOAD_F
#undef SWRITE_KF
#undef SWRITE_VF


}

constexpr int SC_PITCH = 2064;
template <int NREG> __device__ __forceinline__ unsigned long long select_mask(const unsigned (&x)[NREG], int K, int lane) {
    unsigned tau = 0u; bool exact = false;
    for (int bit = 31; bit >= 0; --bit) {
        const unsigned cand = tau | (1u << bit); int c = 0;
#pragma unroll
        for (int i = 0; i < NREG; i += 8) {
            unsigned long long m0, m1, m2, m3, m4, m5, m6, m7;
            asm("v_cmp_ge_u32_e64 %0, %8, %16\n\tv_cmp_ge_u32_e64 %1, %9, %16\n\tv_cmp_ge_u32_e64 %2, %10, %16\n\tv_cmp_ge_u32_e64 %3, %11, %16\n\t"
                "v_cmp_ge_u32_e64 %4, %12, %16\n\tv_cmp_ge_u32_e64 %5, %13, %16\n\tv_cmp_ge_u32_e64 %6, %14, %16\n\tv_cmp_ge_u32_e64 %7, %15, %16"
                : "=&s"(m0), "=&s"(m1), "=&s"(m2), "=&s"(m3), "=&s"(m4), "=&s"(m5), "=&s"(m6), "=&s"(m7)
                : "v"(x[i]), "v"(x[i + 1]), "v"(x[i + 2]), "v"(x[i + 3]), "v"(x[i + 4]), "v"(x[i + 5]), "v"(x[i + 6]), "v"(x[i + 7]), "s"(cand));
            c += ((__popcll(m0) + __popcll(m1)) + (__popcll(m2) + __popcll(m3))) + ((__popcll(m4) + __popcll(m5)) + (__popcll(m6) + __popcll(m7)));
        }
        if (c >= K) { tau = cand; if (c == K) { exact = true; break; } }
    }
    unsigned long long mine = 0ull;
    if (exact) {
#pragma unroll
        for (int i = 0; i < NREG; ++i) { const unsigned long long ms = __ballot(x[i] >= tau); if (lane == i) mine = ms; }
        return mine;
    }
    int cgt = 0;
#pragma unroll
    for (int i = 0; i < NREG; ++i) cgt += __popcll(__ballot(x[i] > tau));
    const int need = K - cgt; int eqt = 0; const unsigned long long lt = (1ull << lane) - 1ull;
#pragma unroll
    for (int i = 0; i < NREG; ++i) {
        const bool gt = x[i] > tau, eq = (x[i] == tau) && (tau != 0u);
        const unsigned long long meq = __ballot(eq);
        const bool sel = gt || (eq && (eqt + __popcll(meq & lt)) < need);
        const unsigned long long ms = __ballot(sel);
        if (lane == i) mine = ms;
        eqt += __popcll(meq);
    }
    return mine;
}
template <int NREG> __device__ __forceinline__ unsigned long long select_query(const LAS float* Sq, int t, int ln) {
    float v[NREG]; unsigned x[NREG];
#pragma unroll
    for (int i = 0; i < NREG; ++i) v[i] = Sq[64 * i];
#pragma unroll
    for (int i = 0; i < NREG; ++i) x[i] = ln <= t - 64 * i ? sortable(v[i]) : 0u;
    return select_mask<NREG>(x, TOPK, ln);
}
__device__ __forceinline__ void idx_unit(Frame& F, int b, int qb) {
    LAS float* S = (LAS float*)F.lds;
    const int lane = F.lane, fr = lane & 15, fq = lane >> 4;
    const int q0 = b * SEQ + 16 * qb;
    bf16x8 bq[16][2]; float wq[16];
    {   const bf16* qp = F.IQB() + (size_t)(q0 + fr) * DIQ + 16 * fq;
#pragma unroll
        for (int h = 0; h < 16; ++h) { bq[h][0] = *(const bf16x8*)(qp + h * 64); bq[h][1] = *(const bf16x8*)(qp + h * 64 + 8); }
        const f32x4* wp = (const f32x4*)(F.IW() + (size_t)(q0 + fr) * NIH);
#pragma unroll
        for (int h4 = 0; h4 < 4; ++h4) { const f32x4 w = wp[h4]; wq[4 * h4] = w[0]; wq[4 * h4 + 1] = w[1]; wq[4 * h4 + 2] = w[2]; wq[4 * h4 + 3] = w[3]; }
    }
    const int nkb = qb + 1;
    const bf16* kbase = F.IKB() + (size_t)(b * SEQ + fr) * IDD + 16 * fq;
    bf16x8 a0, a1;
    if (F.wave < nkb) { a0 = *(const bf16x8*)(kbase + (size_t)(16 * F.wave) * IDD); a1 = *(const bf16x8*)(kbase + (size_t)(16 * F.wave) * IDD + 8); }
    for (int kb = F.wave; kb < nkb; kb += NWAVES) {
        const bf16x8 c0 = a0, c1 = a1;
        if (kb + NWAVES < nkb) { a0 = *(const bf16x8*)(kbase + (size_t)(16 * (kb + NWAVES)) * IDD); a1 = *(const bf16x8*)(kbase + (size_t)(16 * (kb + NWAVES)) * IDD + 8); }
        f32x4 tot = (f32x4){0.f, 0.f, 0.f, 0.f};
#pragma unroll
        for (int h = 0; h < 16; ++h) {
            f32x4 acc = __builtin_amdgcn_mfma_f32_16x16x32_bf16(c0, bq[h][0], (f32x4){0.f, 0.f, 0.f, 0.f}, 0, 0, 0);
            acc = __builtin_amdgcn_mfma_f32_16x16x32_bf16(c1, bq[h][1], acc, 0, 0, 0);
#pragma unroll
            for (int i = 0; i < 4; ++i) tot[i] += wq[h] * relu_i(acc[i]);
        }
        *(LAS f32x4*)(S + fr * SC_PITCH + 16 * kb + 4 * fq) = tot;
    }
    __syncthreads();
#pragma unroll 1
    for (int jq = 0; jq < 2; ++jq) {
        const int ql = 2 * F.wave + jq, t = 16 * qb + ql; unsigned long long mine;
        const int ln = opaque_v(lane); const LAS float* Sq = S + ql * SC_PITCH + ln;
        if (t < TOPK) mine = (lane < 32 && 64 * lane <= t) ? (t - 64 * lane >= 63 ? ~0ull : ((2ull << (t - 64 * lane)) - 1ull)) : 0ull;
        else if (t < 512) mine = select_query<8>(Sq, t, ln);
        else if (t < 1024) mine = select_query<16>(Sq, t, ln);
        else if (t < 1536) mine = select_query<24>(Sq, t, ln);
        else mine = select_query<32>(Sq, t, ln);
        if (lane < 32) F.MASK()[(size_t)(b * SEQ + t) * 32 + lane] = mine;
    }
    __syncthreads();
}
__device__ __forceinline__ void idx_phase(Frame& F) {
    const int c = blockIdx.x, slot = (c >> 3) % 5;
    bool pend = true;
    for (int k = 0;; ++k) {
        const int L = k * F.G + c; const bool more = L < NBATCH * 128;
        if (pend && (k == slot || !more)) { late_transposes(F); p2_pointwise(F); __syncthreads(); pend = false; }
        if (!more) break;
        int b, qb;
        if (F.G == 256) { b = c >> 5; const int r = c & 31; qb = k == 0 ? r : k == 1 ? 63 - r : k == 2 ? 64 + r : 127 - r; }
        else { b = L >> 7; qb = L & 127; }
        idx_unit(F, b, qb);
    }
}

typedef att::BlockRef<bf16, bf16> AttRef;
__device__ __forceinline__ AttRef att_ref(const Frame& F, int L, int pass) {
    const int bh = L >> 2, y = L & 3, b = bh >> 4, h = bh & 15, qb = pass ? 7 - y : y;
    AttRef r; const size_t row0 = (size_t)b * SEQ + (size_t)qb * 256;
    r.Q = F.QB() + row0 * DQ + h * HD; r.O = F.OB() + row0 * DQ + h * HD;
    r.K = F.KB() + (size_t)b * SEQ * DKV + (h >> 2) * HD; r.V = F.VB() + (size_t)b * SEQ * DKV + (h >> 2) * HD;
    r.MW = F.MASK() + row0 * 32; r.P0 = qb * 256;
    return r;
}
__device__ __forceinline__ void att_phase(Frame& F, char* lds) {
    constexpr int TOTAL = NBATCH * 16 * 4;
    int L = blockIdx.x; if (L >= TOTAL) return;
    int pass = 0;
    AttRef cur = att_ref(F, L, 0);
    att::Seam<bf16> S;
    att::causal_swa_prime<bf16, bf16>(cur, SEQ, lds, S);
    for (;;) {
        const bool more_pass = pass == 0, more_item = L + F.G < TOTAL, last = !more_pass && !more_item;
        int passn = pass + 1, Ln = L;
        if (!more_pass) { passn = 0; Ln = more_item ? L + F.G : L; }
        const AttRef nxt = last ? cur : att_ref(F, Ln, passn);
        att::causal_swa_block<bf16, bf16>(cur, nxt, SEQ, SEQ, lds, S);
        if (last) break;
        cur = nxt; pass = passn; L = Ln;
    }
}

__global__ void __launch_bounds__(NWAVES * 64, 2) hybrid_fwd(Args args) {
    extern __shared__ __attribute__((aligned(16))) unsigned char lds[];
    Frame F;
    F.lds = (LAS unsigned char*)lds;
    F.tid = threadIdx.x; F.lane = F.tid & 63; F.wave = __builtin_amdgcn_readfirstlane(F.tid >> 6);
    F.G = gridDim.x; F.gw = blockIdx.x * NWAVES + F.wave; F.NGW = F.G * NWAVES;
    F.a = (const Args CAS*)__builtin_amdgcn_kernarg_segment_ptr();
    unsigned char* ws = F.a->ws;
    for (int u = F.tid; u < (LDS_BYTES - LDSCTL_OFF) / 4; u += NWAVES * 64) ((LAS unsigned*)(F.lds + LDSCTL_OFF))[u] = 0u;
    __syncthreads();
    unsigned* barw = (unsigned*)(ws + WS_CTL) + CW_BAR;
    XcdBarrier bar; bar.bar = barw; bar.x = 0; bar.st = nullptr;
    if (MK_N_LAUNCHES == 1) bar = xcd_barrier_post(barw, (volatile LAS unsigned*)(F.lds + MISC_OFF) + 8);
    const int lo = F.a->ph_lo, hi = F.a->ph_hi;
#define IN(k) (lo <= (k) && (k) < hi)
#define SEAM(k) do { if (IN(k) && IN((k) + 1)) { if (MK_N_LAUNCHES == 1) xcd_barrier(bar); } } while (0)
    LAS unsigned char* ring = F.lds;

    if (IN(0)) { p0_prologue(F); }
    SEAM(0);
    if (IN(1)) {
        pg8::Gemm g{F.XB(), F.WIN(), MP, NZ, DM}; pg8::StaticOrder S; S.init(MP, NZ, F.G, (int)blockIdx.x);
        EpiZ E{F.CB(), F.CCH(), F.QB(), F.KB(), F.VB(), F.IQB(), F.SGA(), F.SGB(), F.out() + O_KP, F.out() + O_VP, F.out() + O_CAP, F.ROPEA(), F.ROPEB()};
        pg8::gemm_phase<EpiZ, pg8::StaticOrder, true, true>(ring, g, S, E);
        __syncthreads();
        ikiw_phase(F);
        skinny_gemm<3>(F, F.XB() + (size_t)MP * DM, F.WIN(), DM, NZ / 16, EpiRawF32{F.ZS(), NZ});
    }
    SEAM(1);
    if (IN(2)) { idx_phase(F); }
    SEAM(2);
    if (IN(3)) {
        pg8::Gemm g{F.A2(), F.WAOUT(), MP, DM, DCONV}; pg8::StaticOrder S; S.init(MP, DM, F.G, (int)blockIdx.x);
        EpiMerge<0> E{F.SGA(), nullptr, F.MA()};
        pg8::gemm_phase<EpiMerge<0>, pg8::StaticOrder, true, true>(ring, g, S, E);
        __syncthreads();
        skinny_gemm_half(F, F.A2() + (size_t)MP * DCONV, F.WAOUT(), DCONV, DM / 16, EpiRawF32{F.YAS(), DM});
        sample_scores(F);
    }
    SEAM(3);
    if (IN(4)) {
        __syncthreads();
        sample_attend(F);
        __syncthreads();
        att_phase(F, (char*)lds);
    }
    SEAM(4);
    if (IN(5)) {
        pg8::Gemm g{F.OB(), F.WATTN(), MP, DM, DQ}; pg8::StaticOrder S; S.init(MP, DM, F.G, (int)blockIdx.x);
        EpiMerge<1> E{F.SGB(), F.MA(), F.MB()};
        pg8::gemm_phase<EpiMerge<1>, pg8::StaticOrder, true, true>(ring, g, S, E);
        __syncthreads();
        const bf16* sga = F.SGA() + (size_t)MP * DM; const bf16* sgb = F.SGB() + (size_t)MP * DM; const float* yas = F.YAS(); bf16* mb = F.MB() + (size_t)MP * DM;
        auto epi = [=](int r, int c, f32x4 v) { const size_t o = (size_t)r * DM + c; const v2u ga = *(const v2u*)(sga + o), gb = *(const v2u*)(sgb + o); const f32x4 ya = *(const f32x4*)(yas + o);
            v2u w; w.x = pk2(bflo(ga.x) * ya[0] + bflo(gb.x) * v[0], bfhi(ga.x) * ya[1] + bfhi(gb.x) * v[1]); w.y = pk2(bflo(ga.y) * ya[2] + bflo(gb.y) * v[2], bfhi(ga.y) * ya[3] + bfhi(gb.y) * v[3]); *(v2u*)(mb + o) = w; };
        skinny_gemm_half(F, F.OB() + (size_t)MP * DQ, F.WATTN(), DQ, DM / 16, epi);
    }
    SEAM(5);
    if (IN(6)) {
        pg8::Gemm g{F.MB(), F.WMIX(), MP, DM, DM}; pg8::StaticOrder S; S.init(MP, DM, F.G, (int)blockIdx.x);
        EpiPre1 E{F.x_p(), F.PRE1B()};
        pg8::gemm_phase<EpiPre1, pg8::StaticOrder, true, true>(ring, g, S, E);
        __syncthreads();
        const float* xs = F.x_s(); bf16* pre = F.PRE1B() + (size_t)MP * DM;
        auto epi = [=](int r, int c, f32x4 v) { const size_t o = (size_t)r * DM + c; const f32x4 y = *(const f32x4*)(xs + o) * ALPHA + v; v2u w; w.x = pk2(y[0], y[1]); w.y = pk2(y[2], y[3]); *(v2u*)(pre + o) = w; };
        skinny_gemm_half(F, F.MB() + (size_t)MP * DM, F.WMIX(), DM, DM / 16, epi);
    }
    SEAM(6);
    if (IN(7)) { ln_rows<true>(F, F.PRE1B(), F.X1B(), F.STATS(), nullptr, F.ln1g(), F.ln1b()); }
    SEAM(7);
    if (IN(8)) {
        pg8::Gemm g{F.X1B(), F.WUG(), MP, NUG, DM}; pg8::StaticOrder S; S.init(MP, NUG, F.G, (int)blockIdx.x);
        EpiHC E{F.UG(), F.HC(), F.out() + O_CFP, F.conv_f_w(), F.conv_f_b(), (LAS float*)(F.lds + HALO_OFF)};
        pg8::gemm_phase<EpiHC, pg8::StaticOrder, true, true>(ring, g, S, E);
        __syncthreads();
        bf16* ug = F.UG() + (size_t)MP * NUG; float* cfs = F.out() + O_CFS;
        auto epi = [=](int r, int c, f32x4 v) { v2u w; w.x = pk2(v[0], v[1]); w.y = pk2(v[2], v[3]); *(v2u*)(ug + (size_t)r * NUG + c) = w;
            const int t = r & 3; if ((c & 128) == 0 && t >= 2) *(f32x4*)(cfs + (size_t)((r >> 2) * 2 + (t - 2)) * DFF + ((c >> 8) << 7) + (c & 127)) = v; };
        skinny_gemm<3>(F, F.X1B() + (size_t)MP * DM, F.WUG(), DM, NUG / 16, epi);
    }
    SEAM(8);
    if (IN(9)) { hc_fix(F); }
    SEAM(9);
    if (IN(10)) {
        pg8::Gemm g{F.HC(), F.WDOWN(), MP, DM, DFF}; pg8::StaticOrder S; S.init(MP, DM, F.G, (int)blockIdx.x);
        EpiPre2 E{F.PRE1B(), F.STATS(), F.ln1g(), F.ln1b(), F.PRE2B()};
        pg8::gemm_phase<EpiPre2, pg8::StaticOrder, true, true>(ring, g, S, E);
        __syncthreads();
        const bf16* p1 = F.PRE1B() + (size_t)MP * DM; const f32x2* st = F.STATS() + MP; const float* lg_ = F.ln1g(); const float* lb_ = F.ln1b(); bf16* p2 = F.PRE2B() + (size_t)MP * DM;
        auto epi = [=](int r, int c, f32x4 v) { const size_t o = (size_t)r * DM + c; const v2u pw = *(const v2u*)(p1 + o); const f32x2 s_ = st[r]; const f32x4 gq = *(const f32x4*)(lg_ + c), bq_ = *(const f32x4*)(lb_ + c);
            f32x4 x; x[0] = bflo(pw.x); x[1] = bfhi(pw.x); x[2] = bflo(pw.y); x[3] = bfhi(pw.y); const f32x4 y = ((x - s_.x) * s_.y * gq + bq_) * ALPHA + v;
            v2u w; w.x = pk2(y[0], y[1]); w.y = pk2(y[2], y[3]); *(v2u*)(p2 + o) = w; };
        skinny_gemm_half(F, F.HC() + (size_t)MP * DFF, F.WDOWN(), DFF, DM / 16, epi);
    }
    SEAM(10);
    if (IN(11)) { ln_rows<false>(F, F.PRE2B(), nullptr, nullptr, F.out() + O_Y, F.ln2g(), F.ln2b()); }
#undef IN
#undef SEAM
}

extern "C" void kernel_launch(void* const* d_in, const int* in_sizes, int n_in, void* d_out, int out_size, void* d_ws, size_t ws_size, hipStream_t stream) {
    static int grid = 0;
    if (grid == 0) {
        if (n_in != 24 || out_size != (int)O_END || ws_size < WS_END) { fprintf(stderr, "kernel_launch: unexpected shapes (n_in %d, out %d, ws %zu); nothing launched\n", n_in, out_size, ws_size); grid = -1; return; }
        int dev = 0, cus = 0, per_cu = 0;
        if (hipGetDevice(&dev) != hipSuccess || hipDeviceGetAttribute(&cus, hipDeviceAttributeMultiprocessorCount, dev) != hipSuccess) { grid = -1; return; }
        if (hipFuncSetAttribute((const void*)hybrid_fwd, hipFuncAttributeMaxDynamicSharedMemorySize, LDS_BYTES) != hipSuccess) { fprintf(stderr, "kernel_launch: hipFuncSetAttribute failed\n"); grid = -1; return; }
        if (hipOccupancyMaxActiveBlocksPerMultiprocessor(&per_cu, (const void*)hybrid_fwd, NWAVES * 64, LDS_BYTES) != hipSuccess || per_cu < 1) { fprintf(stderr, "kernel_launch: occupancy query reports %d blocks per CU\n", per_cu); }
        (void)hipGetLastError();
        grid = cus;
    }
    if (grid < 0) return;
    (void)hipMemsetAsync((char*)d_ws + WS_CTL, 0, CTL_ZERO_BYTES, stream);
    Args a{};
    for (int i = 0; i < 24; ++i) a.in[i] = d_in[i];
    a.out = (float*)d_out; a.ws = (unsigned char*)d_ws;
    if (MK_N_LAUNCHES == 1) { a.ph_lo = 0; a.ph_hi = N_PHASES; hipLaunchKernelGGL(hybrid_fwd, dim3(grid), dim3(NWAVES * 64), LDS_BYTES, stream, a); }
    else for (int p = 0; p < N_PHASES; ++p) { a.ph_lo = p; a.ph_hi = p + 1; hipLaunchKernelGGL(hybrid_fwd, dim3(grid), dim3(NWAVES * 64), LDS_BYTES, stream, a); }
}
```

```cpp
#include <hip/hip_runtime.h>
#include <cstdio>
#include <cstdint>
namespace pg8 {
#define PG8_LAS __attribute__((address_space(3)))
typedef unsigned short bf16_t;
typedef short bf16x8 __attribute__((ext_vector_type(8)));
typedef float f32x4 __attribute__((ext_vector_type(4)));
typedef unsigned u32x4 __attribute__((ext_vector_type(4)));
constexpr int BM = 256, BK = 64, HALF = 128, HTB = HALF * BK * 2  , STAGE_BYTES = 8 * HTB, NXCD = 8, WGM = 8;

__host__ __device__ __forceinline__ int lds_byte(int r, int c) { const int st = (r >> 4) * 2 + (c >> 5), rr = r & 15, cc = c & 31, ob = rr * 64 + cc * 2; return st * 1024 + (ob ^ (((ob >> 9) & 1) << 5)); }
__host__ __device__ __forceinline__ void stage_rc(int b, int& R, int& C) { const int st = b / 1024, sb = b % 1024, swz = sb ^ (((sb >> 9) & 1) << 5); R = (st >> 1) * 16 + swz / 64; C = (st & 1) * 32 + (swz % 64) / 2; }
__host__ __device__ __forceinline__ int perm32(int rho) { const int n = rho >> 4, i = rho & 15; return 8 * (i >> 2) + 4 * n + (i & 3); }

struct Unit { int pm, pn; };
struct Gemm { const bf16_t* A; const bf16_t* Bt; int M, N, K; };

struct StaticOrder {
    int nM, nN, nwg, G, c;
    __host__ __device__ void init(int M, int N, int G_, int c_) { nM = M / BM; nN = N / BM; nwg = nM * nN; G = G_; c = c_; }
    __host__ __device__ bool next(int i, Unit& u) const {
        const long L = (long)i * G + c; if (L >= nwg) return false;
        int wgid = (int)L; { const int q = nwg / NXCD, r = nwg % NXCD, xcd = wgid % NXCD, off = wgid / NXCD; wgid = (xcd < r ? xcd * (q + 1) : r * (q + 1) + (xcd - r) * q) + off; }
        const int nig = WGM * nN, gid = wgid / nig, fm = gid * WGM, gsz = (nM - fm) < WGM ? (nM - fm) : WGM;
        u.pm = fm + ((wgid % nig) % gsz); u.pn = (wgid % nig) / gsz; return true;
    }
    __device__ __forceinline__ void a_ready(const Unit&) const {}
    __device__ __forceinline__ void done(const Unit&) const {}
};

typedef __bf16 bf16x2_hw __attribute__((ext_vector_type(2))); typedef float f32x2_hw __attribute__((ext_vector_type(2)));
__device__ __forceinline__ unsigned cvt_pk_bf16(float lo, float hi) { const f32x2_hw v = {lo, hi}; return __builtin_bit_cast(unsigned, __builtin_convertvector(v, bf16x2_hw)); }
template <class Epi, class Sched, bool ALIGN_EPI = false, bool SP2 = false>
__device__ __forceinline__ void gemm_phase(PG8_LAS unsigned char* lds, const Gemm g, const Sched& S, const Epi& E) {
    const int tid = threadIdx.x, wid = __builtin_amdgcn_readfirstlane(tid >> 6), lane = tid & 63, wr = wid >> 2, wc = wid & 3, fr = lane & 15, fq = lane >> 4;
    const int K = g.K, nt = K / BK;
    unsigned voffA[2], voffB[2];
#pragma unroll
    for (int i = 0; i < 2; ++i) { int R, C; stage_rc(tid * 16 + i * 8192, R, C); const int Rb = Epi::PERM ? ((R & ~31) + perm32(R & 31)) : R;
        voffA[i] = (unsigned)(R * K + C) * 2u; voffB[i] = (unsigned)(Rb * K + C) * 2u; }
    const size_t kstep = (size_t)(BK * 2);
    const size_t hstep = (size_t)HALF * K * 2;
    const size_t tstep = 2 * hstep;
    const unsigned ldsw = (unsigned)wid * 1024u;
    const int aoff = lds_byte(wr * 64 + fr, fq * 8), boff = lds_byte(wc * 32 + fr, fq * 8);
#define PG8_SA(b, h) (((b) * 2 + (h)) * HTB)
#define PG8_SB(b, h) ((4 + (b) * 2 + (h)) * HTB)
#define PG8_STAGE(bufoff, gbase, voff) do { _Pragma("unroll") for (int _i = 0; _i < 2; ++_i) \
        __builtin_amdgcn_global_load_lds((const unsigned*)((const char*)(gbase) + (voff)[_i]), (PG8_LAS unsigned*)(lds + (bufoff) + ldsw + _i * 8192), 16, 0, 0); } while (0)
#define PG8_LDA(dst, b, h) do { _Pragma("unroll") for (int m = 0; m < 4; ++m) _Pragma("unroll") for (int k = 0; k < 2; ++k) dst[m][k] = *(const PG8_LAS bf16x8*)(lds + PG8_SA(b, h) + aoff + m * 2048 + k * 1024); } while (0)
#define PG8_LDB(dst, b, h) do { _Pragma("unroll") for (int n = 0; n < 2; ++n) _Pragma("unroll") for (int k = 0; k < 2; ++k) dst[n][k] = *(const PG8_LAS bf16x8*)(lds + PG8_SB(b, h) + boff + n * 2048 + k * 1024); } while (0)
#define PG8_MMA(ai, bj, At, Bt) do { __builtin_amdgcn_s_setprio(1); _Pragma("unroll") for (int m = 0; m < 4; ++m) _Pragma("unroll") for (int n = 0; n < 2; ++n) _Pragma("unroll") for (int k = 0; k < 2; ++k) \
        acc[ai][bj][m][n] = __builtin_amdgcn_mfma_f32_16x16x32_bf16(Bt[n][k], At[m][k], acc[ai][bj][m][n], 0, 0, 0); __builtin_amdgcn_s_setprio(0); } while (0)
#define PG8_WAIT_V(n) asm volatile("s_waitcnt vmcnt(" #n ")" ::: "memory")
#define PG8_WAIT_L(n) asm volatile("s_waitcnt lgkmcnt(" #n ")" ::: "memory")
#define PG8_BAR __builtin_amdgcn_s_barrier()
#define PG8_SCHED __builtin_amdgcn_sched_barrier(0)
    Unit cur, nxt; int ui = 0;
    if (!S.next(0, cur)) return;
    f32x4 acc[2][2][4][2];
#pragma unroll
    for (int a = 0; a < 2; ++a)
#pragma unroll
        for (int b = 0; b < 2; ++b)
#pragma unroll
            for (int m = 0; m < 4; ++m)
#pragma unroll
                for (int n = 0; n < 2; ++n) acc[a][b][m][n] = (f32x4){0.f, 0.f, 0.f, 0.f};
    bf16x8 At[4][2], B0[2][2], B1[2][2];
    const char* cA = (const char*)g.A + (size_t)cur.pm * tstep; const char* cB = (const char*)g.Bt + (size_t)cur.pn * tstep;
    S.a_ready(cur);
    if constexpr (SP2) {
        PG8_STAGE(PG8_SB(0, 0), cB, voffB); PG8_STAGE(PG8_SB(0, 1), cB + hstep, voffB); PG8_STAGE(PG8_SA(0, 0), cA, voffA); PG8_STAGE(PG8_SA(0, 1), cA + hstep, voffA);
        if (wr == 1) PG8_BAR;
        PG8_WAIT_V(2); PG8_BAR;
        PG8_STAGE(PG8_SB(1, 0), cB + kstep, voffB); PG8_STAGE(PG8_SA(1, 0), cA + kstep, voffA); PG8_STAGE(PG8_SB(1, 1), cB + hstep + kstep, voffB);
        PG8_WAIT_V(6); PG8_BAR;
    } else {
        PG8_STAGE(PG8_SB(0, 0), cB, voffB); PG8_STAGE(PG8_SA(0, 0), cA, voffA); PG8_STAGE(PG8_SB(0, 1), cB + hstep, voffB); PG8_STAGE(PG8_SA(0, 1), cA + hstep, voffA);
        if (wr == 1) PG8_BAR;
        PG8_WAIT_V(4); PG8_BAR;
        PG8_STAGE(PG8_SB(1, 0), cB + kstep, voffB); PG8_STAGE(PG8_SA(1, 0), cA + kstep, voffA); PG8_STAGE(PG8_SB(1, 1), cB + hstep + kstep, voffB);
        PG8_WAIT_V(6); PG8_BAR;
    }
    for (;;) {
        const bool has_next = S.next(ui + 1, nxt);
        const char* nA = has_next ? (const char*)g.A + (size_t)nxt.pm * tstep : cA; const char* nB = has_next ? (const char*)g.Bt + (size_t)nxt.pn * tstep : cB;
        for (int t = 0; t < nt; t += 2) {
            const bool last = (t == nt - 2);
            const char* a1 = cA + (size_t)(t + 1) * kstep;
            const char* a2 = last ? nA : cA + (size_t)(t + 2) * kstep; const char* b2 = last ? nB : cB + (size_t)(t + 2) * kstep;
            const char* a3 = a2 + kstep; const char* b3 = b2 + kstep;
            if (last && has_next) S.a_ready(nxt);
            if constexpr (SP2) {
            PG8_LDB(B0, 0, 0); PG8_LDB(B1, 0, 1); PG8_SCHED; PG8_LDA(At, 0, 0); PG8_STAGE(PG8_SA(1, 1), a1 + hstep, voffA);
            PG8_WAIT_V(8); PG8_WAIT_L(0); PG8_BAR; PG8_MMA(0, 0, At, B0); PG8_MMA(0, 1, At, B1); PG8_BAR; PG8_SCHED;
            PG8_LDA(At, 0, 1); PG8_STAGE(PG8_SB(0, 0), b2, voffB); PG8_STAGE(PG8_SB(0, 1), b2 + hstep, voffB); PG8_STAGE(PG8_SA(0, 0), a2, voffA);
            PG8_WAIT_V(8); PG8_WAIT_L(0); PG8_BAR; PG8_MMA(1, 0, At, B0); PG8_MMA(1, 1, At, B1); PG8_BAR; PG8_SCHED;
            PG8_LDB(B0, 1, 0); PG8_LDB(B1, 1, 1); PG8_SCHED; PG8_LDA(At, 1, 0); PG8_STAGE(PG8_SA(0, 1), a2 + hstep, voffA);
            PG8_WAIT_V(8); PG8_WAIT_L(0); PG8_BAR; PG8_MMA(0, 0, At, B0); PG8_MMA(0, 1, At, B1); PG8_BAR; PG8_SCHED;
            PG8_LDA(At, 1, 1); PG8_STAGE(PG8_SB(1, 0), b3, voffB); PG8_STAGE(PG8_SB(1, 1), b3 + hstep, voffB); PG8_STAGE(PG8_SA(1, 0), a3, voffA);
            PG8_WAIT_V(8); PG8_WAIT_L(0); PG8_BAR; PG8_MMA(1, 0, At, B0); PG8_MMA(1, 1, At, B1); PG8_BAR; PG8_SCHED;
            } else {
            PG8_LDB(B0, 0, 0); PG8_SCHED; PG8_LDA(At, 0, 0); PG8_STAGE(PG8_SA(1, 1), a1 + hstep, voffA);
            PG8_WAIT_L(8); PG8_BAR; PG8_WAIT_L(0); PG8_MMA(0, 0, At, B0); PG8_BAR; PG8_SCHED;
            PG8_LDB(B1, 0, 1); PG8_STAGE(PG8_SB(0, 0), b2, voffB);
            PG8_BAR; PG8_WAIT_L(0); PG8_MMA(0, 1, At, B1); PG8_BAR;
            PG8_LDA(At, 0, 1); PG8_STAGE(PG8_SA(0, 0), a2, voffA);
            PG8_BAR; PG8_WAIT_L(0); PG8_MMA(1, 0, At, B0); PG8_BAR; PG8_SCHED;
            PG8_STAGE(PG8_SB(0, 1), b2 + hstep, voffB);
            PG8_WAIT_V(6); PG8_BAR; PG8_MMA(1, 1, At, B1); PG8_BAR;
            PG8_LDB(B0, 1, 0); PG8_SCHED; PG8_LDA(At, 1, 0); PG8_STAGE(PG8_SA(0, 1), a2 + hstep, voffA);
            PG8_WAIT_L(8); PG8_BAR; PG8_WAIT_L(0); PG8_MMA(0, 0, At, B0); PG8_BAR; PG8_SCHED;
            PG8_LDB(B1, 1, 1); PG8_STAGE(PG8_SB(1, 0), b3, voffB);
            PG8_BAR; PG8_WAIT_L(0); PG8_MMA(0, 1, At, B1); PG8_BAR;
            PG8_LDA(At, 1, 1); PG8_STAGE(PG8_SA(1, 0), a3, voffA);
            PG8_BAR; PG8_WAIT_L(0); PG8_MMA(1, 0, At, B0); PG8_BAR; PG8_SCHED;
            PG8_STAGE(PG8_SB(1, 1), b3 + hstep, voffB);
            PG8_WAIT_V(6); PG8_BAR; PG8_MMA(1, 1, At, B1); PG8_BAR;
            }
        }
        if constexpr (ALIGN_EPI) { if (wr == 0) PG8_BAR; }
        if constexpr (!Epi::AFTER_DRAIN) { E(acc, cur, wr, wc, fr, fq); S.done(cur); }
        if (!has_next) break;
#pragma unroll
        for (int a = 0; a < 2; ++a)
#pragma unroll
            for (int b = 0; b < 2; ++b)
#pragma unroll
                for (int m = 0; m < 4; ++m)
#pragma unroll
                    for (int n = 0; n < 2; ++n) acc[a][b][m][n] = (f32x4){0.f, 0.f, 0.f, 0.f};
        cur = nxt; cA = nA; cB = nB; ++ui;
        if constexpr (ALIGN_EPI) { if (wr == 1) PG8_BAR; }
    }
    PG8_WAIT_V(0);
    if constexpr (!ALIGN_EPI) { if (wr == 0) PG8_BAR; }
    PG8_BAR;
    if constexpr (Epi::AFTER_DRAIN) { E.fused(acc, cur, wr, wc, fr, fq, lds, wid, lane); S.done(cur); }
#undef PG8_SA
#undef PG8_SB
#undef PG8_STAGE
#undef PG8_LDA
#undef PG8_LDB
#undef PG8_MMA
#undef PG8_WAIT_V
#undef PG8_WAIT_L
#undef PG8_BAR
#undef PG8_SCHED
}
}

#ifndef MK_N_LAUNCHES
#define MK_N_LAUNCHES 1
#endif
constexpr int NWAVES = 8;
constexpr int N_PHASES = 12;

constexpr int DM = 2048, NBATCH = 8, SEQ = 2048, MP = NBATCH * SEQ, DECB = 32, DECS = 4, MS = DECB * DECS, MALL = MP + MS;
constexpr int PAST = 8192, PAGE = 128, NPAGES = PAST / PAGE;
constexpr int DCONV = 1024, NKV = 4, HD = 128, NIH = 16, IDD = 64, TOPK = 256, DFF = 5632;
constexpr int DQ = 2048, DKV = 512, DIQ = 1024, DIN = 11344;
constexpr int NZ = 11264;
constexpr int NUG = 2 * DFF;
constexpr int SSC_PITCH = 8256;
constexpr float LN_EPS = 1e-5f;
constexpr float ALPHA = 1.189207115002721f;

constexpr size_t O_Y = 0, O_KP = 33816576, O_VP = 42205184, O_IKP = 50593792, O_CAP = 51642368, O_CFP = 51658752,
                 O_KS = 51748864, O_VS = 51814400, O_IKS = 51879936, O_CAS = 51888128, O_CFS = 51953664, O_END = 52314112;

constexpr size_t MiB = 1u << 20;
constexpr size_t WS_CTL = 0, CTL_ZERO_BYTES = 32768;
constexpr size_t WS_ROPEA = 1 * MiB, WS_ROPEB = 1 * MiB + 512 * 1024;
constexpr size_t WS_WIN = 2 * MiB, WS_WAOUT = 48 * MiB, WS_WATTN = 52 * MiB, WS_WMIX = 60 * MiB, WS_WUG = 68 * MiB, WS_WDOWN = 112 * MiB;
constexpr size_t WS_XB = 136 * MiB, WS_CB = 202 * MiB, WS_CCH = 235 * MiB, WS_QB = 268 * MiB, WS_KB = 334 * MiB, WS_VB = 351 * MiB, WS_IQB = 368 * MiB;
constexpr size_t WS_IKB = 401 * MiB, WS_IW = 404 * MiB, WS_SGA = 406 * MiB, WS_SGB = 472 * MiB, WS_A2 = 538 * MiB, WS_MA = 571 * MiB, WS_OB = 637 * MiB, WS_MB = 703 * MiB;
constexpr size_t WS_PRE1 = 769 * MiB, WS_PRE2 = 840 * MiB, WS_STATS = 910 * MiB, WS_X1B = 1029 * MiB, WS_UG = 1095 * MiB, WS_HC = 1451 * MiB, WS_ZS = 1629 * MiB, WS_YAS = 1635 * MiB;
constexpr size_t WS_SSC = 1636 * MiB, WS_MASK = 1641 * MiB, WS_END = 1645 * MiB;
constexpr int CW_BAR = 4096;

constexpr int RING_BYTES = 135168;
constexpr int LDSCTL_OFF = RING_BYTES, MISC_OFF = LDSCTL_OFF + 320;
constexpr int HALO_OFF = MISC_OFF + 128;
constexpr int LDS_BYTES = 147456;

#define GAS __attribute__((address_space(1)))
#define LAS __attribute__((address_space(3)))
typedef unsigned short bf16;
typedef unsigned v4u __attribute__((ext_vector_type(4)));
typedef unsigned v2u __attribute__((ext_vector_type(2)));
typedef float f32x4 __attribute__((ext_vector_type(4)));
typedef float f32x2 __attribute__((ext_vector_type(2)));
typedef short bf16x8 __attribute__((ext_vector_type(8)));
#define LDS_WAIT() asm volatile("s_waitcnt lgkmcnt(0)" ::: "memory")
#define VM_WAIT() asm volatile("s_waitcnt vmcnt(0)" ::: "memory")
__device__ __forceinline__ unsigned f2bf(float f) { unsigned u = __builtin_bit_cast(unsigned, f); return (u + 0x7fffu + ((u >> 16) & 1u)) >> 16; }
__device__ __forceinline__ unsigned pk2(float lo, float hi) { return pg8::cvt_pk_bf16(lo, hi); }
__device__ __forceinline__ float bflo(unsigned w) { return __builtin_bit_cast(float, w << 16); }
__device__ __forceinline__ float bfhi(unsigned w) { return __builtin_bit_cast(float, w & 0xffff0000u); }
__device__ __forceinline__ float bf1(bf16 h) { return __builtin_bit_cast(float, ((unsigned)h) << 16); }
__device__ __forceinline__ void unpack8(v4u w, float (&f)[8]) { f[0] = bflo(w.x); f[1] = bfhi(w.x); f[2] = bflo(w.y); f[3] = bfhi(w.y); f[4] = bflo(w.z); f[5] = bfhi(w.z); f[6] = bflo(w.w); f[7] = bfhi(w.w); }
__device__ __forceinline__ v4u pack8(const float (&f)[8]) { v4u w; w.x = pk2(f[0], f[1]); w.y = pk2(f[2], f[3]); w.z = pk2(f[4], f[5]); w.w = pk2(f[6], f[7]); return w; }
__device__ __forceinline__ void zero8(float (&f)[8]) { f[0] = f[1] = f[2] = f[3] = f[4] = f[5] = f[6] = f[7] = 0.f; }
__device__ __forceinline__ float sigmoidf_(float x) { return __builtin_amdgcn_rcpf(1.0f + __builtin_amdgcn_exp2f(-1.4426950408889634f * x)); }
__device__ __forceinline__ float sigmoid_fast(float x) { return sigmoidf_(x); }
__device__ __forceinline__ float gelu_tanh(float x) { const float p = __builtin_fmaf(x * x, 0.10294324f, 2.3022082f); const float r = __builtin_amdgcn_rcpf(__builtin_amdgcn_exp2f(x * p) + 1.0f); return __builtin_fmaf(-x, r, x); }
__device__ __forceinline__ float wave_sum(float v) {
#pragma unroll
    for (int o = 1; o < 64; o <<= 1) v += __shfl_xor(v, o);
    return v;
}
__device__ __forceinline__ float wave_max(float v) {
#pragma unroll
    for (int o = 1; o < 64; o <<= 1) v = fmaxf(v, __shfl_xor(v, o));
    return v;
}
__device__ __forceinline__ int pos_index(int row) { return row < MP ? (row & (SEQ - 1)) : SEQ + ((row - MP) & (DECS - 1)); }

#define XB_TMO      128
#define XB_XCNT(j)  (256  + 64 * (j))
#define XB_XSUB(j)  (1280 + 64 * (j))
#define XB_XGEN(j)  (2304 + 64 * (j))
#define XB_TOP      3328
#define XB_TOPGEN   3392
#define XCD_BAR_WORDS 3456
#define XB_SPIN_CAP (1u << 18)

__device__ __forceinline__ unsigned xb_ld(unsigned* p)              { return __hip_atomic_load(p, __ATOMIC_RELAXED, __HIP_MEMORY_SCOPE_AGENT); }
__device__ __forceinline__ unsigned xb_add(unsigned* p, unsigned v) { return __hip_atomic_fetch_add(p, v, __ATOMIC_RELAXED, __HIP_MEMORY_SCOPE_AGENT); }
__device__ __forceinline__ unsigned xb_xcc_id() { return (unsigned)__builtin_amdgcn_s_getreg((3 << 11) | 20) & 0xFu; }
#define XB_SPIN(cond, bar) do { unsigned _sp = 0; while (cond) { __builtin_amdgcn_s_sleep(1); \
    if ((++_sp & 255u) == 0u) { if (xb_ld(&(bar)[XB_TMO])) break; if (_sp > XB_SPIN_CAP) { atomicAdd(&(bar)[XB_TMO], 1u); break; } } } } while (0)

struct XcdBarrier {
    unsigned* bar; unsigned x;
    volatile LAS unsigned* st;
};

__device__ __forceinline__ XcdBarrier xcd_barrier_post(unsigned* bar, volatile LAS unsigned* st) {
    XcdBarrier b; b.bar = bar; b.x = xb_xcc_id(); b.st = st;
    if (threadIdx.x == 0) (void)xb_add(&bar[XB_XCNT(b.x)], 1u);
    return b;
}
__device__ __forceinline__ void xcd_barrier_complete(unsigned* bar, unsigned x, unsigned& nloc, unsigned& nx) {
    const unsigned G = gridDim.x * gridDim.y * gridDim.z;
    unsigned sum, cnt, mine, sp = 0u;
    for (;;) {
        sum = 0u; cnt = 0u; mine = 0u;
#pragma unroll
        for (unsigned j = 0; j < 16; ++j) { const unsigned c = xb_ld(&bar[XB_XCNT(j)]); sum += c; cnt += (c > 0u) ? 1u : 0u; mine = (j == x) ? c : mine; }
        if (sum == G) break;
        __builtin_amdgcn_s_sleep(1);
        if ((++sp & 255u) == 0u) { if (xb_ld(&bar[XB_TMO])) break; if (sp > XB_SPIN_CAP) { atomicAdd(&bar[XB_TMO], 1u); break; } }
    }
    nloc = mine > 0u ? mine : 1u; nx = cnt > 0u ? cnt : 1u;
}

__device__ __forceinline__ void xcd_barrier(const XcdBarrier& b) {
    asm volatile("s_waitcnt vmcnt(0)" ::: "memory");
    __syncthreads();
    if (threadIdx.x == 0) {
        unsigned* bar = b.bar;
        __builtin_amdgcn_s_waitcnt(0);
        unsigned nloc = b.st[0], nx = b.st[1];
        if (nloc == 0u) { xcd_barrier_complete(bar, b.x, nloc, nx); b.st[0] = nloc; b.st[1] = nx; }
        const unsigned old = xb_add(&bar[XB_XSUB(b.x)], 1u);
        const unsigned gen = old / nloc;
        if (old + 1u == (gen + 1u) * nloc) {
            __builtin_amdgcn_fence(__ATOMIC_RELEASE, "agent");
            asm volatile("s_waitcnt vmcnt(0)" ::: "memory");
            const unsigned og = xb_add(&bar[XB_TOP], 1u);
            const unsigned tg = og / nx;
            if (og + 1u == (tg + 1u) * nx) xb_add(&bar[XB_TOPGEN], 1u);
            else XB_SPIN(xb_ld(&bar[XB_TOPGEN]) == tg, bar);
            __builtin_amdgcn_fence(__ATOMIC_ACQUIRE, "agent");
            xb_add(&bar[XB_XGEN(b.x)], 1u);
            asm volatile("s_waitcnt vmcnt(0)" ::: "memory");
        } else {
            XB_SPIN(xb_ld(&bar[XB_XGEN(b.x)]) == gen, bar);
            __builtin_amdgcn_fence(__ATOMIC_ACQUIRE, "agent");
            asm volatile("s_waitcnt vmcnt(0)" ::: "memory");
        }
    }
    __syncthreads();
}

#define CAS __attribute__((address_space(4)))
struct Args { const void* in[24]; float* out; unsigned char* ws; int ph_lo, ph_hi; };
struct Frame {
    LAS unsigned char* lds;
    int tid, lane, wave, G, gw, NGW;
    const Args CAS* a;
    __device__ __forceinline__ bf16* WIN() const { return (bf16*)(a->ws + WS_WIN); }
    __device__ __forceinline__ bf16* WAOUT() const { return (bf16*)(a->ws + WS_WAOUT); }
    __device__ __forceinline__ bf16* WATTN() const { return (bf16*)(a->ws + WS_WATTN); }
    __device__ __forceinline__ bf16* WMIX() const { return (bf16*)(a->ws + WS_WMIX); }
    __device__ __forceinline__ bf16* WUG() const { return (bf16*)(a->ws + WS_WUG); }
    __device__ __forceinline__ bf16* WDOWN() const { return (bf16*)(a->ws + WS_WDOWN); }
    __device__ __forceinline__ bf16* XB() const { return (bf16*)(a->ws + WS_XB); }
    __device__ __forceinline__ bf16* CB() const { return (bf16*)(a->ws + WS_CB); }
    __device__ __forceinline__ bf16* CCH() const { return (bf16*)(a->ws + WS_CCH); }
    __device__ __forceinline__ bf16* QB() const { return (bf16*)(a->ws + WS_QB); }
    __device__ __forceinline__ bf16* KB() const { return (bf16*)(a->ws + WS_KB); }
    __device__ __forceinline__ bf16* VB() const { return (bf16*)(a->ws + WS_VB); }
    __device__ __forceinline__ bf16* IQB() const { return (bf16*)(a->ws + WS_IQB); }
    __device__ __forceinline__ bf16* IKB() const { return (bf16*)(a->ws + WS_IKB); }
    __device__ __forceinline__ bf16* SGA() const { return (bf16*)(a->ws + WS_SGA); }
    __device__ __forceinline__ bf16* SGB() const { return (bf16*)(a->ws + WS_SGB); }
    __device__ __forceinline__ bf16* A2() const { return (bf16*)(a->ws + WS_A2); }
    __device__ __forceinline__ bf16* MA() const { return (bf16*)(a->ws + WS_MA); }
    __device__ __forceinline__ bf16* OB() const { return (bf16*)(a->ws + WS_OB); }
    __device__ __forceinline__ bf16* MB() const { return (bf16*)(a->ws + WS_MB); }
    __device__ __forceinline__ bf16* X1B() const { return (bf16*)(a->ws + WS_X1B); }
    __device__ __forceinline__ bf16* UG() const { return (bf16*)(a->ws + WS_UG); }
    __device__ __forceinline__ bf16* HC() const { return (bf16*)(a->ws + WS_HC); }
    __device__ __forceinline__ float* IW() const { return (float*)(a->ws + WS_IW); }
    __device__ __forceinline__ bf16* PRE1B() const { return (bf16*)(a->ws + WS_PRE1); }
    __device__ __forceinline__ bf16* PRE2B() const { return (bf16*)(a->ws + WS_PRE2); }
    __device__ __forceinline__ f32x2* STATS() const { return (f32x2*)(a->ws + WS_STATS); }
    __device__ __forceinline__ float* ZS() const { return (float*)(a->ws + WS_ZS); }
    __device__ __forceinline__ float* YAS() const { return (float*)(a->ws + WS_YAS); }
    __device__ __forceinline__ float* SSC() const { return (float*)(a->ws + WS_SSC); }
    __device__ __forceinline__ f32x2* ROPEA() const { return (f32x2*)(a->ws + WS_ROPEA); }
    __device__ __forceinline__ f32x2* ROPEB() const { return (f32x2*)(a->ws + WS_ROPEB); }
    __device__ __forceinline__ unsigned long long* MASK() const { return (unsigned long long*)(a->ws + WS_MASK); }
    __device__ __forceinline__ const float* x_p() const { return (const float*)a->in[0]; }
    __device__ __forceinline__ const float* x_s() const { return (const float*)a->in[1]; }
    __device__ __forceinline__ const float* cache_k() const { return (const float*)a->in[2]; }
    __device__ __forceinline__ const float* cache_v() const { return (const float*)a->in[3]; }
    __device__ __forceinline__ const float* cache_ik() const { return (const float*)a->in[4]; }
    __device__ __forceinline__ const float* st_a() const { return (const float*)a->in[5]; }
    __device__ __forceinline__ const float* st_f() const { return (const float*)a->in[6]; }
    __device__ __forceinline__ const int* ptab() const { return (const int*)a->in[7]; }
    __device__ __forceinline__ const float* w_in() const { return (const float*)a->in[8]; }
    __device__ __forceinline__ const float* ikg() const { return (const float*)a->in[9]; }
    __device__ __forceinline__ const float* ikb() const { return (const float*)a->in[10]; }
    __device__ __forceinline__ const float* conv_a_w() const { return (const float*)a->in[11]; }
    __device__ __forceinline__ const float* w_a_out() const { return (const float*)a->in[12]; }
    __device__ __forceinline__ const float* w_attn_out() const { return (const float*)a->in[13]; }
    __device__ __forceinline__ const float* w_mix_out() const { return (const float*)a->in[14]; }
    __device__ __forceinline__ const float* ln1g() const { return (const float*)a->in[15]; }
    __device__ __forceinline__ const float* ln1b() const { return (const float*)a->in[16]; }
    __device__ __forceinline__ const float* w_up() const { return (const float*)a->in[17]; }
    __device__ __forceinline__ const float* w_gate() const { return (const float*)a->in[18]; }
    __device__ __forceinline__ const float* conv_f_w() const { return (const float*)a->in[19]; }
    __device__ __forceinline__ const float* conv_f_b() const { return (const float*)a->in[20]; }
    __device__ __forceinline__ const float* w_down() const { return (const float*)a->in[21]; }
    __device__ __forceinline__ const float* ln2g() const { return (const float*)a->in[22]; }
    __device__ __forceinline__ const float* ln2b() const { return (const float*)a->in[23]; }
    __device__ __forceinline__ float* out() const { return a->out; }
};

using pg8::Unit;
__device__ __forceinline__ v4u pk8v(f32x4 a, f32x4 b) { v4u w; w.x = pg8::cvt_pk_bf16(a[0], a[1]); w.y = pg8::cvt_pk_bf16(a[2], a[3]); w.z = pg8::cvt_pk_bf16(b[0], b[1]); w.w = pg8::cvt_pk_bf16(b[2], b[3]); return w; }
__device__ __forceinline__ f32x4 sig4(f32x4 a) { f32x4 r; r[0] = sigmoid_fast(a[0]); r[1] = sigmoid_fast(a[1]); r[2] = sigmoid_fast(a[2]); r[3] = sigmoid_fast(a[3]); return r; }
__device__ __forceinline__ f32x4 shfl4(f32x4 a, int m) { f32x4 r; r[0] = __shfl_xor(a[0], m); r[1] = __shfl_xor(a[1], m); r[2] = __shfl_xor(a[2], m); r[3] = __shfl_xor(a[3], m); return r; }
__device__ __forceinline__ void bf8_to_f(v4u w, f32x4& a, f32x4& b) { a[0] = bflo(w.x); a[1] = bfhi(w.x); a[2] = bflo(w.y); a[3] = bfhi(w.y); b[0] = bflo(w.z); b[1] = bfhi(w.z); b[2] = bflo(w.w); b[3] = bfhi(w.w); }

struct EpiZ {
    static constexpr bool PERM = true, AFTER_DRAIN = false;
    bf16 *CB, *CCH, *QB, *KB, *VB, *IQB, *SGA, *SGB; float *kout, *vout, *caout; const f32x2 *ropeA, *ropeB;
    __device__ __forceinline__ void operator()(const f32x4 (&acc)[2][2][4][2], const Unit& u, int wr, int wc, int fr, int fq) const {
        const int pn = u.pn, row0 = u.pm * 256 + wr * 64 + fr, lc = wc * 32 + 8 * fq;
        if (pn < 4) {
#pragma unroll
            for (int ai = 0; ai < 2; ++ai)
#pragma unroll
                for (int m = 0; m < 4; ++m) { const size_t row = row0 + ai * 128 + m * 16;
#pragma unroll
                    for (int bj = 0; bj < 2; ++bj) *(v4u*)(CB + row * DCONV + pn * 256 + bj * 128 + lc) = pk8v(acc[ai][bj][m][0], acc[ai][bj][m][1]); }
        } else if (pn < 12) {
            const int c0 = (pn - 4) * 128 + lc;
#pragma unroll
            for (int ai = 0; ai < 2; ++ai)
#pragma unroll
                for (int m = 0; m < 4; ++m) { const int row = row0 + ai * 128 + m * 16; const int t = row & (SEQ - 1);
                    const f32x4 p0 = acc[ai][0][m][0] * acc[ai][1][m][0], p1 = acc[ai][0][m][1] * acc[ai][1][m][1];
                    *(v4u*)(CCH + (size_t)row * DCONV + c0) = pk8v(p0, p1);
                    if (t >= SEQ - 2) { float* o = caout + ((size_t)((row >> 11) * 2 + (t - (SEQ - 2)))) * DCONV + c0; *(f32x4*)o = p0; *(f32x4*)(o + 4) = p1; } }
        } else if (pn < 22) {
            const bool isk = pn >= 20;
            const float sgn = fq < 2 ? -1.f : 1.f;
#pragma unroll
            for (int ai = 0; ai < 2; ++ai)
#pragma unroll
                for (int m = 0; m < 4; ++m) { const int row = row0 + ai * 128 + m * 16; const int t = row & (SEQ - 1);
                    f32x4 cs[4];
                    if (wc == 0) { const f32x4* rp = (const f32x4*)(ropeA + t * 16 + 8 * (fq & 1));
#pragma unroll
                        for (int e = 0; e < 4; ++e) cs[e] = rp[e]; }
#pragma unroll
                    for (int bj = 0; bj < 2; ++bj) { f32x4 v0 = acc[ai][bj][m][0], v1 = acc[ai][bj][m][1];
                        if (wc == 0) { const f32x4 o0 = shfl4(v0, 32), o1 = shfl4(v1, 32);
                            v0[0] = v0[0] * cs[0][0] + sgn * o0[0] * cs[0][1]; v0[1] = v0[1] * cs[0][2] + sgn * o0[1] * cs[0][3];
                            v0[2] = v0[2] * cs[1][0] + sgn * o0[2] * cs[1][1]; v0[3] = v0[3] * cs[1][2] + sgn * o0[3] * cs[1][3];
                            v1[0] = v1[0] * cs[2][0] + sgn * o1[0] * cs[2][1]; v1[1] = v1[1] * cs[2][2] + sgn * o1[1] * cs[2][3];
                            v1[2] = v1[2] * cs[3][0] + sgn * o1[2] * cs[3][1]; v1[3] = v1[3] * cs[3][2] + sgn * o1[3] * cs[3][3]; }
                        if (!isk) *(v4u*)(QB + (size_t)row * DQ + (pn - 12) * 256 + bj * 128 + lc) = pk8v(v0, v1);
                        else { const size_t o = (size_t)row * DKV + (pn - 20) * 256 + bj * 128 + lc; *(v4u*)(KB + o) = pk8v(v0, v1); __builtin_nontemporal_store(v0, (f32x4*)(kout + o)); __builtin_nontemporal_store(v1, (f32x4*)(kout + o + 4)); } } }
        } else if (pn < 24) {
#pragma unroll
            for (int ai = 0; ai < 2; ++ai)
#pragma unroll
                for (int m = 0; m < 4; ++m) { const size_t row = row0 + ai * 128 + m * 16;
#pragma unroll
                    for (int bj = 0; bj < 2; ++bj) { const size_t o = row * DKV + (pn - 22) * 256 + bj * 128 + lc; const f32x4 v0 = acc[ai][bj][m][0], v1 = acc[ai][bj][m][1];
                        *(v4u*)(VB + o) = pk8v(v0, v1); __builtin_nontemporal_store(v0, (f32x4*)(vout + o)); __builtin_nontemporal_store(v1, (f32x4*)(vout + o + 4)); } }
        } else if (pn < 28) {
            const bool rw = (wc & 1) == 0; const float sgn = fq == 0 ? -1.f : 1.f;
#pragma unroll
            for (int ai = 0; ai < 2; ++ai)
#pragma unroll
                for (int m = 0; m < 4; ++m) { const int row = row0 + ai * 128 + m * 16; const int t = row & (SEQ - 1);
                    f32x4 cs[4];
                    if (rw) { const f32x4* rp = (const f32x4*)(ropeB + t * 8);
#pragma unroll
                        for (int e = 0; e < 4; ++e) cs[e] = rp[e]; }
#pragma unroll
                    for (int bj = 0; bj < 2; ++bj) { f32x4 v0 = acc[ai][bj][m][0], v1 = acc[ai][bj][m][1];
                        if (rw) { const f32x4 o0 = shfl4(v0, 16), o1 = shfl4(v1, 16);
                            if (fq < 2) {
                            v0[0] = v0[0] * cs[0][0] + sgn * o0[0] * cs[0][1]; v0[1] = v0[1] * cs[0][2] + sgn * o0[1] * cs[0][3];
                            v0[2] = v0[2] * cs[1][0] + sgn * o0[2] * cs[1][1]; v0[3] = v0[3] * cs[1][2] + sgn * o0[3] * cs[1][3];
                            v1[0] = v1[0] * cs[2][0] + sgn * o1[0] * cs[2][1]; v1[1] = v1[1] * cs[2][2] + sgn * o1[1] * cs[2][3];
                            v1[2] = v1[2] * cs[3][0] + sgn * o1[2] * cs[3][1]; v1[3] = v1[3] * cs[3][2] + sgn * o1[3] * cs[3][3]; } }
                        *(v4u*)(IQB + (size_t)row * DIQ + (pn - 24) * 256 + bj * 128 + lc) = pk8v(v0, v1); } }
        } else {
            bf16* G_ = pn < 36 ? SGA : SGB; const int cb = (pn < 36 ? pn - 28 : pn - 36) * 256;
#pragma unroll
            for (int ai = 0; ai < 2; ++ai)
#pragma unroll
                for (int m = 0; m < 4; ++m) { const size_t row = row0 + ai * 128 + m * 16;
#pragma unroll
                    for (int bj = 0; bj < 2; ++bj) *(v4u*)(G_ + row * DM + cb + bj * 128 + lc) = pk8v(sig4(acc[ai][bj][m][0]), sig4(acc[ai][bj][m][1])); }
        }
    }
};
template <int MODE> struct EpiMerge {
    static constexpr bool PERM = true, AFTER_DRAIN = false;
    const bf16* SG; const bf16* MAin; bf16* O;
    __device__ __forceinline__ void operator()(const f32x4 (&acc)[2][2][4][2], const Unit& u, int wr, int wc, int fr, int fq) const {
        const int row0 = u.pm * 256 + wr * 64 + fr, col0 = u.pn * 256 + wc * 32 + 8 * fq;
#pragma unroll
        for (int ai = 0; ai < 2; ++ai)
#pragma unroll
            for (int m = 0; m < 4; ++m) { const size_t row = row0 + ai * 128 + m * 16;
#pragma unroll
                for (int bj = 0; bj < 2; ++bj) { const size_t o = row * DM + col0 + bj * 128; f32x4 g0, g1; bf8_to_f(*(const v4u*)(SG + o), g0, g1);
                    f32x4 r0 = g0 * acc[ai][bj][m][0], r1 = g1 * acc[ai][bj][m][1];
                    if (MODE == 1) { f32x4 a0, a1; bf8_to_f(*(const v4u*)(MAin + o), a0, a1); r0 += a0; r1 += a1; }
                    *(v4u*)(O + o) = pk8v(r0, r1); } }
    }
};
struct EpiPre1 {
    static constexpr bool PERM = true, AFTER_DRAIN = false;
    const float* X; bf16* O;
    __device__ __forceinline__ void operator()(const f32x4 (&acc)[2][2][4][2], const Unit& u, int wr, int wc, int fr, int fq) const {
        const int row0 = u.pm * 256 + wr * 64 + fr, col0 = u.pn * 256 + wc * 32 + 8 * fq;
#pragma unroll
        for (int ai = 0; ai < 2; ++ai)
#pragma unroll
            for (int m = 0; m < 4; ++m) { const size_t ro = (size_t)(row0 + ai * 128 + m * 16) * DM + col0;
#pragma unroll
                for (int bj = 0; bj < 2; ++bj) { const size_t o = ro + bj * 128; const f32x4 x0 = *(const f32x4*)(X + o), x1 = *(const f32x4*)(X + o + 4);
                    *(v4u*)(O + o) = pk8v(x0 * ALPHA + acc[ai][bj][m][0], x1 * ALPHA + acc[ai][bj][m][1]); } }
    }
};
struct EpiPre2 {
    static constexpr bool PERM = true, AFTER_DRAIN = false;
    const bf16* P1; const f32x2* ST; const float* G; const float* Bt_; bf16* O;
    __device__ __forceinline__ void operator()(const f32x4 (&acc)[2][2][4][2], const Unit& u, int wr, int wc, int fr, int fq) const {
        const int row0 = u.pm * 256 + wr * 64 + fr, col0 = u.pn * 256 + wc * 32 + 8 * fq;
        f32x4 gv[2][2], bv[2][2];
#pragma unroll
        for (int bj = 0; bj < 2; ++bj)
#pragma unroll
            for (int n = 0; n < 2; ++n) { gv[bj][n] = *(const f32x4*)(G + col0 + bj * 128 + 4 * n); bv[bj][n] = *(const f32x4*)(Bt_ + col0 + bj * 128 + 4 * n); }
#pragma unroll
        for (int ai = 0; ai < 2; ++ai)
#pragma unroll
            for (int m = 0; m < 4; ++m) { const int row = row0 + ai * 128 + m * 16; const f32x2 st = ST[row]; const size_t ro = (size_t)row * DM + col0;
#pragma unroll
                for (int bj = 0; bj < 2; ++bj) { const size_t o = ro + bj * 128; f32x4 p0, p1; bf8_to_f(*(const v4u*)(P1 + o), p0, p1);
                    const f32x4 x0 = (p0 - st.x) * st.y * gv[bj][0] + bv[bj][0], x1 = (p1 - st.x) * st.y * gv[bj][1] + bv[bj][1];
                    *(v4u*)(O + o) = pk8v(x0 * ALPHA + acc[ai][bj][m][0], x1 * ALPHA + acc[ai][bj][m][1]); } }
    }
};
__device__ __forceinline__ float dpp_shr1(float old, float x) { return __builtin_bit_cast(float, __builtin_amdgcn_update_dpp(__builtin_bit_cast(int, old), __builtin_bit_cast(int, x), 0x111, 0xf, 0xf, false)); }
__device__ __forceinline__ float dpp_shr2(float old, float x) { return __builtin_bit_cast(float, __builtin_amdgcn_update_dpp(__builtin_bit_cast(int, old), __builtin_bit_cast(int, x), 0x112, 0xf, 0xf, false)); }
__device__ __forceinline__ float dpp_ror1(float x) { return __builtin_bit_cast(float, __builtin_amdgcn_update_dpp(0, __builtin_bit_cast(int, x), 0x121, 0xf, 0xf, false)); }
__device__ __forceinline__ float dpp_ror2(float x) { return __builtin_bit_cast(float, __builtin_amdgcn_update_dpp(0, __builtin_bit_cast(int, x), 0x122, 0xf, 0xf, false)); }
__device__ __forceinline__ f32x2 gelu_tanh2(f32x2 x) {
    const f32x2 p = (x * x) * 0.10294324f + 2.3022082f; const f32x2 a = x * p;
    f32x2 e; e.x = __builtin_amdgcn_exp2f(a.x); e.y = __builtin_amdgcn_exp2f(a.y); e = e + 1.0f;
    f32x2 r; r.x = __builtin_amdgcn_rcpf(e.x); r.y = __builtin_amdgcn_rcpf(e.y);
    return x - x * r;
}
struct EpiHC {
    static constexpr bool PERM = true, AFTER_DRAIN = false;
    bf16* UG; bf16* HC; float* cfout; const float* cw; const float* cbias; LAS float* halo;
    __device__ __forceinline__ void operator()(const f32x4 (&acc)[2][2][4][2], const Unit& u, int wr, int wc, int fr, int fq) const {
        const int lc = wc * 32 + 8 * fq, f0 = u.pn * 128 + lc, row0 = u.pm * 256 + wr * 64 + fr;
        if (fr >= 14) {
#pragma unroll
            for (int ai = 0; ai < 2; ++ai) { LAS float* h = halo + (((2 * ai + wr) * 2 + (fr - 14)) * 128 + lc); *(LAS f32x4*)h = acc[ai][0][3][0]; *(LAS f32x4*)(h + 4) = acc[ai][0][3][1]; } }
        asm volatile("s_waitcnt lgkmcnt(0)" ::: "memory"); __builtin_amdgcn_s_barrier(); asm volatile("" ::: "memory");
        f32x2 w0[4], w1[4], w2[4], bb[4];
        {   const f32x2* p = (const f32x2*)(cw + f0); const f32x2* q = (const f32x2*)(cbias + f0);
#pragma unroll
            for (int k = 0; k < 4; ++k) { w0[k] = p[k]; w1[k] = p[DFF / 2 + k]; w2[k] = p[DFF + k]; bb[k] = q[k]; } }
        const bool seq0 = (u.pm & 7) == 0;
#pragma unroll
        for (int ai = 0; ai < 2; ++ai) {
            const int grp = 2 * ai + wr;
#pragma unroll
            for (int m = 0; m < 4; ++m) {
                const int row = row0 + ai * 128 + m * 16, t = row & (SEQ - 1), trow = 64 * grp + 16 * m + fr;
                float r[8];
#pragma unroll
                for (int e2 = 0; e2 < 4; ++e2) {
                    f32x2 x, gv, u1, u2;
#pragma unroll
                    for (int k = 0; k < 2; ++k) { const int e = 2 * e2 + k;
                        const float xe = acc[ai][0][m][e >> 2][e & 3];
                        float o1, o2;
                        if (m == 0) { float p15, p14; if (grp == 0) { p15 = 0.f; p14 = 0.f; } else { p15 = halo[((grp - 1) * 2 + 1) * 128 + lc + e]; p14 = halo[((grp - 1) * 2) * 128 + lc + e]; }
                            o1 = p15; o2 = fr == 1 ? p15 : p14; }
                        else { const float pvx = acc[ai][0][m > 0 ? m - 1 : 0][e >> 2][e & 3]; o1 = dpp_ror1(pvx); o2 = dpp_ror2(pvx); }
                        x[k] = xe; gv[k] = acc[ai][1][m][e >> 2][e & 3]; u1[k] = dpp_shr1(o1, xe); u2[k] = dpp_shr2(o2, xe); }
                    const f32x2 y = gelu_tanh2(w0[e2] * u2 + w1[e2] * u1 + w2[e2] * x + bb[e2]) * gv;
                    r[2 * e2] = y.x; r[2 * e2 + 1] = y.y;
                }
                if (trow >= 2 || seq0) *(v4u*)(HC + (size_t)row * DFF + f0) = pack8(r);
                if (trow < 2 || trow >= 254) { *(v4u*)(UG + (size_t)row * NUG + u.pn * 256 + lc) = pk8v(acc[ai][0][m][0], acc[ai][0][m][1]); if (trow < 2) *(v4u*)(UG + (size_t)row * NUG + u.pn * 256 + 128 + lc) = pk8v(acc[ai][1][m][0], acc[ai][1][m][1]); }
                if (t >= SEQ - 2) { float* o = cfout + ((size_t)((row >> 11) * 2 + (t - (SEQ - 2)))) * DFF + f0; *(f32x4*)o = acc[ai][0][m][0]; *(f32x4*)(o + 4) = acc[ai][0][m][1]; }
                asm volatile("" ::: "memory");
            }
        }
    }
};

template <int MT, int NTB, int NTW>
__device__ __forceinline__ void mini_gemm(const Frame& F, const bf16* A0, const bf16* B0, int K, int bvalid, f32x4 (&acc)[NTW]) {
    constexpr int R = (MT + NTB) * 16, PITCH = 272, BUF = R * PITCH, NP = (R * 16 + 511) / 512;
    static_assert(2 * BUF <= 100000, "mini_gemm LDS");
    const int fr = F.lane & 15, fq = F.lane >> 4, mt = F.wave % MT, ng = F.wave / MT;
    const bf16* src[NP]; int dst[NP];
#pragma unroll
    for (int i = 0; i < NP; ++i) { int p = F.tid + 512 * i; p = p < R * 16 ? p : R * 16 - 1;
        const int row = p >> 4, pc = p & 15; int br = row - MT * 16; br = br < bvalid ? br : bvalid - 1;
        src[i] = (row < MT * 16 ? A0 + (size_t)row * K : B0 + (size_t)br * K) + pc * 8; dst[i] = row * PITCH + pc * 16; }
    const int aoff = (mt * 16 + fr) * PITCH + fq * 16; int boff[NTW];
#pragma unroll
    for (int j = 0; j < NTW; ++j) { int tl = ng * NTW + j; tl = tl < NTB ? tl : NTB - 1; boff[j] = (MT * 16 + tl * 16 + fr) * PITCH + fq * 16; acc[j] = (f32x4){0.f, 0.f, 0.f, 0.f}; }
    const int nc = K >> 7;
    v4u st[4][NP];
#define MG_LOAD(slot, c) do { _Pragma("unroll") for (int i = 0; i < NP; ++i) st[slot][i] = *(const v4u*)(src[i] + (size_t)(c) * 128); } while (0)
#define MG_STEP(slot, c) do { if ((c) + 3 < nc) MG_LOAD(((slot) + 3) & 3, (c) + 3);                                                                                  \
        { LAS unsigned char* wb = F.lds + ((c) & 1) * BUF; _Pragma("unroll") for (int i = 0; i < NP; ++i) *(LAS v4u*)(wb + dst[i]) = st[slot][i]; }                   \
        asm volatile("s_waitcnt lgkmcnt(0)" ::: "memory"); __builtin_amdgcn_s_barrier(); asm volatile("" ::: "memory");                                              \
        { const LAS unsigned char* rb = F.lds + ((c) & 1) * BUF; _Pragma("unroll") for (int s = 0; s < 4; ++s) { const bf16x8 a = *(const LAS bf16x8*)(rb + aoff + s * 64); \
            _Pragma("unroll") for (int j = 0; j < NTW; ++j) acc[j] = __builtin_amdgcn_mfma_f32_16x16x32_bf16(*(const LAS bf16x8*)(rb + boff[j] + s * 64), a, acc[j], 0, 0, 0); } } } while (0)
    MG_LOAD(0, 0); MG_LOAD(1, 1); MG_LOAD(2, 2);
#pragma unroll 1
    for (int c = 0; c < nc; c += 4) { MG_STEP(0, c); MG_STEP(1, c + 1); MG_STEP(2, c + 2); MG_STEP(3, c + 3); }
    asm volatile("s_waitcnt lgkmcnt(0)" ::: "memory"); __builtin_amdgcn_s_barrier(); asm volatile("" ::: "memory");
#undef MG_LOAD
#undef MG_STEP
}
template <int NT, class E>
__device__ __forceinline__ void skinny_gemm(const Frame& F, const bf16* A, const bf16* Bt, int K, int ntn, const E& epi) {
    const int fr = F.lane & 15, fq = F.lane >> 4; const int nitems = (ntn + NT - 1) / NT;
    for (int it = blockIdx.x; it < nitems; it += F.G) {
        f32x4 acc[NT];
        mini_gemm<8, NT, NT>(F, A, Bt + (size_t)(it * NT * 16) * K, K, (ntn - it * NT) * 16, acc);
#pragma unroll
        for (int j = 0; j < NT; ++j) { const int tl = it * NT + j; if (tl < ntn) epi(16 * F.wave + fr, 16 * tl + 4 * fq, acc[j]); }
    }
}

template <class E>
__device__ __forceinline__ void skinny_gemm_half(const Frame& F, const bf16* A, const bf16* Bt, int K, int ntn, const E& epi) {
    const int fr = F.lane & 15, fq = F.lane >> 4;
    for (int it = blockIdx.x; it < 2 * ntn; it += F.G) {
        const int tl = it >> 1, rh = it & 1; f32x4 acc[1];
        mini_gemm<4, 1, 1>(F, A + (size_t)(rh * 64) * K, Bt + (size_t)(tl * 16) * K, K, 16, acc);
        if (F.wave < 4) epi(64 * rh + 16 * F.wave + fr, 16 * tl + 4 * fq, acc[0]);
    }
}

template <int MAP> __device__ __forceinline__ int phys_row(int l) {
    if (MAP == 0) return l;
    if (MAP == 1) {
        if (l < 1024) return l;
        if (l < 2048) { const int c = l - 1024; return 1024 + ((c >> 7) << 8) + (c & 127); }
        if (l < 3072) { const int c = l - 2048; return 1024 + ((c >> 7) << 8) + 128 + (c & 127); }
        if (l < 7168) return l;
        if (l < 7248) return NZ + (l - 7168);
        return l - 80; }
    if (MAP == 2) return ((l >> 7) << 8) + (l & 127);
    return ((l >> 7) << 8) + 128 + (l & 127);
}
template <int MAP> __device__ __forceinline__ void transpose_item(const float* W, int K, int N, bf16* WT, LAS float* scr, int item, int lane) {
    const int nblk = (N + 63) / 64, kb = item / nblk, nb = item % nblk, k0 = 64 * kb, n0 = 64 * nb;
    const int l16 = lane & 15, kq = lane >> 4, nn = n0 + 4 * l16;
    f32x4 v[16];
#pragma unroll
    for (int i = 0; i < 16; ++i) v[i] = nn < N ? __builtin_nontemporal_load((const f32x4*)(W + (size_t)(k0 + 4 * i + kq) * N + nn)) : (f32x4){0.f, 0.f, 0.f, 0.f};
#pragma unroll
    for (int i = 0; i < 16; ++i) { LAS float* s = scr + (4 * i + kq) * 65 + 4 * l16; s[0] = v[i][0]; s[1] = v[i][1]; s[2] = v[i][2]; s[3] = v[i][3]; }
    LDS_WAIT();
    const int c = lane & 7;
#pragma unroll
    for (int j = 0; j < 8; ++j) { const int n = (lane >> 3) + 8 * j; const LAS float* s = scr + (8 * c) * 65 + n;
        v4u o; o.x = pk2(s[0 * 65], s[1 * 65]); o.y = pk2(s[2 * 65], s[3 * 65]); o.z = pk2(s[4 * 65], s[5 * 65]); o.w = pk2(s[6 * 65], s[7 * 65]);
        if (n0 + n < N) *(v4u*)(WT + (size_t)phys_row<MAP>(n0 + n) * K + k0 + 8 * c) = o; }
    LDS_WAIT();
}
__device__ __forceinline__ void sincos_d(double a, float& c, float& s) {
    const double k = __builtin_rint(a * 0.63661977236758134308); const double y = (a - k * 1.57079632679489655800) - k * 6.12323399573676603587e-17; const double y2 = y * y;
    double sy = y * (1.0 + y2 * (-1.0 / 6 + y2 * (1.0 / 120 + y2 * (-1.0 / 5040 + y2 * (1.0 / 362880 + y2 * (-1.0 / 39916800 + y2 * (1.0 / 6227020800.0)))))));
    double cy = 1.0 + y2 * (-0.5 + y2 * (1.0 / 24 + y2 * (-1.0 / 720 + y2 * (1.0 / 40320 + y2 * (-1.0 / 3628800 + y2 * (1.0 / 479001600.0 + y2 * (-1.0 / 87178291200.0)))))));
    const int q = ((int)(long long)k) & 3;
    const double ss = (q & 1) ? cy : sy, cc = (q & 1) ? sy : cy;
    s = (float)((q & 2) ? -ss : ss); c = (float)(((q + 1) & 2) ? -cc : cc);
}
__device__ __forceinline__ void late_transposes(Frame& F) {
    LAS float* scr = (LAS float*)(F.lds + F.wave * 16640);
    int lane = F.lane; asm volatile("" : "+v"(lane));
    constexpr int I_AT = 32 * 32, I_MX = 32 * 32, I_UP = 32 * 88, I_GT = 32 * 88, I_DN = 88 * 32;
    constexpr int NITEMS = I_AT + I_MX + I_UP + I_GT + I_DN;
    for (int it = F.gw; it < NITEMS; it += F.NGW) {
        int r = it;
        if (r < I_AT) { transpose_item<0>(F.w_attn_out(), DQ, DM, F.WATTN(), scr, r, lane); continue; } r -= I_AT;
        if (r < I_MX) { transpose_item<0>(F.w_mix_out(), DM, DM, F.WMIX(), scr, r, lane); continue; } r -= I_MX;
        if (r < I_UP) { transpose_item<2>(F.w_up(), DM, DFF, F.WUG(), scr, r, lane); continue; } r -= I_UP;
        if (r < I_GT) { transpose_item<3>(F.w_gate(), DM, DFF, F.WUG(), scr, r, lane); continue; } r -= I_GT;
        transpose_item<0>(F.w_down(), DFF, DM, F.WDOWN(), scr, r, lane);
    }
}
__device__ __forceinline__ void p0_prologue(Frame& F) {
    LAS float* scr = (LAS float*)(F.lds + F.wave * 16640);
    constexpr int I_IN = 32 * 178, I_AO = 16 * 32;
    for (int it = F.gw; it < I_IN + I_AO; it += F.NGW) {
        if (it < I_IN) transpose_item<1>(F.w_in(), DM, DIN, F.WIN(), scr, it, F.lane);
        else transpose_item<0>(F.w_a_out(), DCONV, DM, F.WAOUT(), scr, it - I_IN, F.lane);
    }
    for (int m = F.gw; m < MALL; m += F.NGW) {
        const f32x4* xr = (const f32x4*)(m < MP ? F.x_p() + (size_t)m * DM : F.x_s() + (size_t)(m - MP) * DM) + 2 * F.lane;
        v4u* o = (v4u*)(F.XB() + (size_t)m * DM) + F.lane;
#pragma unroll
        for (int j = 0; j < 4; ++j) { const f32x4 a = __builtin_nontemporal_load(xr + 128 * j), b = __builtin_nontemporal_load(xr + 128 * j + 1); o[64 * j] = pk8v(a, b); }
    }
    const double fa[16] = {1.0, 0.44036660267178046, 0.19392274474868576, 0.08539710028576561, 0.03760603093086393, 0.016560440080994446, 0.007292664737217109, 0.003211445994752591,
                           0.001414213562373095, 0.000622772421914596, 0.0002742481756762073, 0.00012076973741146504, 5.318295896944988e-05, 2.341999896140934e-05, 1.031338537721246e-05, 4.5416704806078695e-06};
    for (int e = blockIdx.x * 512 + F.tid; e < (SEQ + DECS) * 24; e += F.G * 512) {
        const int pi = e / 24, j = e % 24; const double pos = pi < SEQ ? (double)pi : (double)(PAST + pi - SEQ);
        double fr_ = 1.0;
#pragma unroll
        for (int i = 0; i < 16; ++i) { const int want = j < 16 ? j : 2 * (j - 16); if (i == want) fr_ = fa[i]; }
        float c, s; sincos_d(pos * fr_, c, s);
        if (j < 16) F.ROPEA()[pi * 16 + j] = (f32x2){c, s}; else F.ROPEB()[pi * 8 + (j - 16)] = (f32x2){c, s};
    }
}

__device__ __forceinline__ void ikiw_phase(Frame& F) {
    LAS float* T = (LAS float*)(F.lds + 81920);
    const int fr = F.lane & 15, fq = F.lane >> 4, mt = F.wave & 3, ng = F.wave >> 2;
    for (int k = 0;; ++k) {
        int rb = blockIdx.x + k * F.G;
        if (F.G == 256 && k == 1) { if (blockIdx.x < 254) break; rb = blockIdx.x + 2; }
        if (rb >= MALL / 64) break;
        f32x4 acc[3];
        mini_gemm<4, 5, 3>(F, F.XB() + (size_t)(rb * 64) * DM, F.WIN() + (size_t)NZ * DM, DM, 80, acc);
#pragma unroll
        for (int j = 0; j < 3; ++j) { const int tl = ng * 3 + j; if (tl < 5) {
#pragma unroll
            for (int i = 0; i < 4; ++i) T[(mt * 16 + fr) * 81 + 16 * tl + 4 * fq + i] = acc[j][i]; } }
        __syncthreads();
        {   const int row = F.tid >> 3, g8 = F.tid & 7, grow = rb * 64 + row;
            float v[8]; float s = 0.f;
#pragma unroll
            for (int e = 0; e < 8; ++e) { v[e] = T[row * 81 + 8 * g8 + e]; s += v[e]; }
            s += __shfl_xor(s, 1); s += __shfl_xor(s, 2); s += __shfl_xor(s, 4);
            const float mean = s * (1.f / 64.f); float q = 0.f;
#pragma unroll
            for (int e = 0; e < 8; ++e) { v[e] -= mean; q += v[e] * v[e]; }
            q += __shfl_xor(q, 1); q += __shfl_xor(q, 2); q += __shfl_xor(q, 4);
            const float rstd = 1.0f / sqrtf(q * (1.f / 64.f) + LN_EPS);
            float y[8], o[8];
#pragma unroll
            for (int e = 0; e < 8; ++e) y[e] = v[e] * rstd * F.ikg()[8 * g8 + e] + F.ikb()[8 * g8 + e];
#pragma unroll
            for (int e = 0; e < 8; ++e) o[e] = __shfl_xor(y[e], 1);
            const f32x2* rp = F.ROPEB() + pos_index(grow) * 8;
            if (g8 < 2) { const float sgn = g8 == 0 ? -1.f : 1.f;
#pragma unroll
                for (int e = 0; e < 8; ++e) { const f32x2 cs = rp[e]; y[e] = y[e] * cs.x + sgn * o[e] * cs.y; } }
            *(v4u*)(F.IKB() + (size_t)grow * IDD + 8 * g8) = pack8(y);
            float* op = grow < MP ? F.out() + O_IKP + (size_t)grow * IDD + 8 * g8 : F.out() + O_IKS + (size_t)(grow - MP) * IDD + 8 * g8;
            *(f32x4*)op = (f32x4){y[0], y[1], y[2], y[3]}; *(f32x4*)(op + 4) = (f32x4){y[4], y[5], y[6], y[7]};
            if (g8 < 2) {
#pragma unroll
                for (int e = 0; e < 8; ++e) F.IW()[(size_t)grow * NIH + 8 * g8 + e] = T[row * 81 + 64 + 8 * g8 + e] * (0.25f * 0.125f); }
        }
        __syncthreads();
    }
}
struct EpiRawF32 { float* O; int ld; __device__ __forceinline__ void operator()(int r, int c, f32x4 v) const { *(f32x4*)(O + (size_t)r * ld + c) = v; } };

__device__ __forceinline__ void p2_pointwise(Frame& F) {
    const int gt = blockIdx.x * 512 + F.tid, NT_ = F.G * 512;
    for (int it = gt; it < MP * 128; it += NT_) {
        const int row = it >> 7, c0 = (it & 127) * 8, t = row & (SEQ - 1);
        float cb[8], u0[8], u1[8], u2[8], r[8];
        unpack8(*(const v4u*)(F.CB() + (size_t)row * DCONV + c0), cb);
        unpack8(*(const v4u*)(F.CCH() + (size_t)row * DCONV + c0), u2);
        if (t >= 1) unpack8(*(const v4u*)(F.CCH() + (size_t)(row - 1) * DCONV + c0), u1); else zero8(u1);
        if (t >= 2) unpack8(*(const v4u*)(F.CCH() + (size_t)(row - 2) * DCONV + c0), u0); else zero8(u0);
#pragma unroll
        for (int e = 0; e < 8; ++e) r[e] = cb[e] * (F.conv_a_w()[c0 + e] * u0[e] + F.conv_a_w()[DCONV + c0 + e] * u1[e] + F.conv_a_w()[2 * DCONV + c0 + e] * u2[e]);
        *(v4u*)(F.A2() + (size_t)row * DCONV + c0) = pack8(r);
    }
    const float* Z = F.ZS();
    for (int it = gt; it < MS * DCONV; it += NT_) {
        const int r = it >> 10, c = it & 1023, b = r >> 2, t = r & 3; const int pcc = 1024 + ((c >> 7) << 8) + (c & 127), pch = pcc + 128;
        float ext[3];
#pragma unroll
        for (int j = 0; j < 3; ++j) { const int i = t + j; ext[j] = i < 2 ? F.st_a()[(size_t)(b * 2 + i) * DCONV + c] : Z[(size_t)(4 * b + i - 2) * NZ + pcc] * Z[(size_t)(4 * b + i - 2) * NZ + pch]; }
        const float y = F.conv_a_w()[c] * ext[0] + F.conv_a_w()[DCONV + c] * ext[1] + F.conv_a_w()[2 * DCONV + c] * ext[2];
        F.A2()[(size_t)(MP + r) * DCONV + c] = (bf16)f2bf(Z[(size_t)r * NZ + c] * y);
        if (t >= 2) F.out()[O_CAS + (size_t)(b * 2 + (t - 2)) * DCONV + c] = ext[2];
    }
    for (int it = gt; it < MS * DQ; it += NT_) {
        const int r = it >> 11, col = it & 2047, d = col & 127, t = r & 3, p = 3072 + col; float v = Z[(size_t)r * NZ + p];
        if (d < 32) { const f32x2 cs = F.ROPEA()[(SEQ + t) * 16 + (d & 15)]; v = d < 16 ? v * cs.x - Z[(size_t)r * NZ + p + 16] * cs.y : v * cs.x + Z[(size_t)r * NZ + p - 16] * cs.y; }
        F.QB()[(size_t)(MP + r) * DQ + col] = (bf16)f2bf(v);
    }
    for (int it = gt; it < MS * DKV; it += NT_) {
        const int r = it >> 9, col = it & 511, d = col & 127, t = r & 3, p = 5120 + col; float v = Z[(size_t)r * NZ + p];
        if (d < 32) { const f32x2 cs = F.ROPEA()[(SEQ + t) * 16 + (d & 15)]; v = d < 16 ? v * cs.x - Z[(size_t)r * NZ + p + 16] * cs.y : v * cs.x + Z[(size_t)r * NZ + p - 16] * cs.y; }
        F.KB()[(size_t)(MP + r) * DKV + col] = (bf16)f2bf(v); F.out()[O_KS + (size_t)r * DKV + col] = v;
        const float vv = Z[(size_t)r * NZ + 5632 + col];
        F.VB()[(size_t)(MP + r) * DKV + col] = (bf16)f2bf(vv); F.out()[O_VS + (size_t)r * DKV + col] = vv;
    }
    for (int it = gt; it < MS * DIQ; it += NT_) {
        const int r = it >> 10, col = it & 1023, d = col & 63, t = r & 3, p = 6144 + col; float v = Z[(size_t)r * NZ + p];
        if (d < 16) { const f32x2 cs = F.ROPEB()[(SEQ + t) * 8 + (d & 7)]; v = d < 8 ? v * cs.x - Z[(size_t)r * NZ + p + 8] * cs.y : v * cs.x + Z[(size_t)r * NZ + p - 8] * cs.y; }
        F.IQB()[(size_t)(MP + r) * DIQ + col] = (bf16)f2bf(v);
    }
    for (int it = gt; it < MS * DM; it += NT_) {
        const int r = it >> 11, col = it & 2047;
        F.SGA()[(size_t)(MP + r) * DM + col] = (bf16)f2bf(sigmoidf_(Z[(size_t)r * NZ + 7168 + col]));
        F.SGB()[(size_t)(MP + r) * DM + col] = (bf16)f2bf(sigmoidf_(Z[(size_t)r * NZ + 9216 + col]));
    }
}

__device__ __forceinline__ float relu_i(float x) { const int i = __builtin_bit_cast(int, x); return __builtin_bit_cast(float, i > 0 ? i : 0); }
__device__ __forceinline__ int opaque_v(int v) { asm volatile("" : "+v"(v)); return v; }
__device__ __forceinline__ unsigned sortable(float f) { const unsigned b = __builtin_bit_cast(unsigned, f); return b ^ ((unsigned)((int)b >> 31) | 0x80000000u); }

__device__ __forceinline__ void sample_scores(Frame& F) {
    const int lane = F.lane, fr = lane & 15, fq = lane >> 4; const bool lo = lane < 32, b4 = (lane & 16) != 0;
    for (int it = blockIdx.x; it < DECB * 8; it += F.G) {
        const int b = it >> 3, c = it & 7;
        bf16x8 aq[4][2]; f32x4 wq[4];
#pragma unroll
        for (int t = 0; t < 4; ++t) { const bf16* qp = F.IQB() + (size_t)(MP + 4 * b + t) * DIQ + fr * IDD + 16 * fq; aq[t][0] = *(const bf16x8*)qp; aq[t][1] = *(const bf16x8*)(qp + 8);
            wq[t] = *(const f32x4*)(F.IW() + (size_t)(MP + 4 * b + t) * NIH + 4 * fq); }
        const int* pt = F.ptab() + b * NPAGES + c * 8; float* ssc = F.SSC() + (size_t)(4 * b + fq) * SSC_PITCH + c * 1024 + fr;
        f32x4 kv[2][4];
#define SS_LOAD(slot, kb) do { const int pg_ = pt[(kb) >> 3]; const f32x4* kp_ = (const f32x4*)(F.cache_ik() + ((size_t)pg_ * PAGE + ((kb) & 7) * 16 + fr) * IDD + 16 * fq); \
        _Pragma("unroll") for (int i_ = 0; i_ < 4; ++i_) kv[slot][i_] = kp_[i_]; } while (0)
#define SS_SCORE(b0_, b1_, out_) do { float p_[4]; _Pragma("unroll") for (int t = 0; t < 4; ++t) { \
            f32x4 acc_ = __builtin_amdgcn_mfma_f32_16x16x32_bf16(aq[t][0], b0_, (f32x4){0.f, 0.f, 0.f, 0.f}, 0, 0, 0); acc_ = __builtin_amdgcn_mfma_f32_16x16x32_bf16(aq[t][1], b1_, acc_, 0, 0, 0); \
            p_[t] = wq[t][0] * relu_i(acc_[0]) + wq[t][1] * relu_i(acc_[1]) + wq[t][2] * relu_i(acc_[2]) + wq[t][3] * relu_i(acc_[3]); } \
        const float r0_ = __shfl_xor(lo ? p_[2] : p_[0], 32), r1_ = __shfl_xor(lo ? p_[3] : p_[1], 32); const float a0_ = (lo ? p_[0] : p_[2]) + r0_, a1_ = (lo ? p_[1] : p_[3]) + r1_; \
        out_ = (b4 ? a1_ : a0_) + __shfl_xor(b4 ? a0_ : a1_, 16); } while (0)
        SS_LOAD(0, F.wave);
#pragma unroll
        for (int j = 0; j < 8; ++j) {
            const int kb = F.wave + 8 * j;
            if (j + 1 < 8) SS_LOAD((j + 1) & 1, kb + 8);
            bf16x8 b0, b1; { const v4u w0 = pk8v(kv[j & 1][0], kv[j & 1][1]), w1 = pk8v(kv[j & 1][2], kv[j & 1][3]); b0 = __builtin_bit_cast(bf16x8, w0); b1 = __builtin_bit_cast(bf16x8, w1); }
            float sc; SS_SCORE(b0, b1, sc);
            ssc[16 * kb] = sc;
        }
        if (c == 7 && F.wave == 0) {
            const bf16* kp = F.IKB() + (size_t)(MP + 4 * b + (fr < DECS ? fr : DECS - 1)) * IDD + 16 * fq;
            const bf16x8 b0 = *(const bf16x8*)kp, b1 = *(const bf16x8*)(kp + 8);
            float sc; SS_SCORE(b0, b1, sc);
            if (fr < DECS) F.SSC()[(size_t)(4 * b + fq) * SSC_PITCH + PAST + fr] = sc;
        }
#undef SS_LOAD
#undef SS_SCORE
    }
}
__device__ __forceinline__ void sample_attend(Frame& F) {
    LAS int* lst = (LAS int*)F.lds;
    LAS int* rid = (LAS int*)(F.lds + 1024);
    LAS float* qf = (LAS float*)(F.lds + 2048);
    LAS float* lg = (LAS float*)(F.lds + 2048 + 4096);
    LAS int* cnt = (LAS int*)(F.lds + 2048 + 4096 + 8192);
    LAS float* op = (LAS float*)(F.lds + 2048 + 4096 + 8192 + 128);
    const int lane = F.lane, kvl = F.wave >> 2, qt = F.wave & 3;
    for (int item = blockIdx.x; item < 2 * MS; item += F.G) {
        const int r = item >> 1, hp = item & 1, b = r >> 2, t = r & 3, kvh = 2 * hp + kvl;
        __syncthreads();
        {
            unsigned x[17]; const int ln = opaque_v(lane); const float* sp = F.SSC() + (size_t)r * SSC_PITCH + 1024 * F.wave + ln;
#pragma unroll
            for (int i = 0; i < 16; ++i) x[i] = sortable(sp[64 * i]);
            x[16] = (F.wave == 7 && ln <= t) ? sortable(F.SSC()[(size_t)r * SSC_PITCH + PAST + ln]) : 0u;
            unsigned tau = 0u;
            for (int bit = 31; bit >= 0; --bit) {
                const unsigned cand = tau | (1u << bit); int c = 0;
#pragma unroll
                for (int i = 0; i < 17; ++i) c += __popcll(__ballot(x[i] >= cand));
                LAS int* cb = cnt + (bit & 1) * 8;
                if (lane == 0) cb[F.wave] = c;
                __syncthreads();
                int tot = 0;
#pragma unroll
                for (int w = 0; w < 8; ++w) tot += cb[w];
                if (tot >= TOPK) tau = cand;
            }
            int cg = 0, ce = 0;
#pragma unroll
            for (int i = 0; i < 17; ++i) { cg += __popcll(__ballot(x[i] > tau)); ce += __popcll(__ballot(x[i] == tau)); }
            if (lane == 0) { cnt[16 + F.wave] = cg; cnt[24 + F.wave] = ce; }
            __syncthreads();
            int gtot = 0;
#pragma unroll
            for (int w = 0; w < 8; ++w) gtot += cnt[16 + w];
            const int need = TOPK - gtot;
            int base = 0, eqb = 0;
#pragma unroll
            for (int w = 0; w < 8; ++w) if (w < F.wave) { const int e_ = cnt[24 + w]; int k_ = need - eqb; k_ = k_ < 0 ? 0 : (k_ > e_ ? e_ : k_); base += cnt[16 + w] + k_; eqb += e_; }
            const unsigned long long lt = (1ull << ln) - 1ull;
#pragma unroll
            for (int i = 0; i < 17; ++i) {
                const bool gt = x[i] > tau, eq = x[i] == tau;
                const unsigned long long meq = __ballot(eq);
                const bool sel = gt || (eq && (eqb + __popcll(meq & lt)) < need);
                const unsigned long long ms = __ballot(sel);
                if (sel) lst[base + __popcll(ms & lt)] = i < 16 ? 1024 * F.wave + 64 * i + ln : PAST + ln;
                base += __popcll(ms); eqb += __popcll(meq);
            }
        }
        if (F.tid < 128) { const v4u* qp = (const v4u*)(F.QB() + (size_t)(MP + r) * DQ + hp * 8 * HD); float f[8]; unpack8(qp[F.tid], f);
#pragma unroll
            for (int e = 0; e < 8; ++e) qf[F.tid * 8 + e] = f[e]; }
        __syncthreads();
        if (F.tid < TOPK) { const int idx = lst[F.tid]; rid[F.tid] = idx < PAST ? F.ptab()[b * NPAGES + (idx >> 7)] * PAGE + (idx & 127) : -(idx - PAST) - 1; }
        __syncthreads();
        {
            float q0[4], q1[4];
#pragma unroll
            for (int g = 0; g < 4; ++g) { q0[g] = qf[(4 * kvl + g) * HD + 2 * lane]; q1[g] = qf[(4 * kvl + g) * HD + 2 * lane + 1]; }
            const float* ck = F.cache_k() + (size_t)kvh * HD + 2 * lane; const bf16* nk = F.KB() + (size_t)(MP + 4 * b) * DKV + kvh * HD + 2 * lane;
#pragma unroll 1
            for (int jb = 0; jb < 4; ++jb) {
                f32x2 kv[16];
#pragma unroll
                for (int u = 0; u < 16; ++u) { const int rr = rid[64 * qt + 16 * jb + u];
                    if (rr >= 0) kv[u] = *(const f32x2*)(ck + (size_t)rr * (NKV * HD)); else { const unsigned w = *(const unsigned*)(nk + (size_t)(-rr - 1) * DKV); kv[u] = (f32x2){bflo(w), bfhi(w)}; } }
#pragma unroll
                for (int u = 0; u < 16; ++u) {
                    float v[4];
#pragma unroll
                    for (int g = 0; g < 4; ++g) v[g] = q0[g] * kv[u].x + q1[g] * kv[u].y;
                    const bool lo = lane < 32;
                    const float r0 = __shfl_xor(lo ? v[2] : v[0], 32), r1 = __shfl_xor(lo ? v[3] : v[1], 32);
                    const float a0 = (lo ? v[0] : v[2]) + r0, a1 = (lo ? v[1] : v[3]) + r1;
                    const bool b4 = (lane & 16) != 0;
                    float c = (b4 ? a1 : a0) + __shfl_xor(b4 ? a0 : a1, 16);
                    c += __shfl_xor(c, 8); c += __shfl_xor(c, 4); c += __shfl_xor(c, 2); c += __shfl_xor(c, 1);
                    if ((lane & 15) == 0) lg[(4 * kvl + (lane >> 4)) * 256 + 64 * qt + 16 * jb + u] = c * 0.08838834764831845f;
                }
            }
        }
        __syncthreads();
        {
            LAS float* l = lg + F.wave * 256; float x4[4];
#pragma unroll
            for (int jj = 0; jj < 4; ++jj) x4[jj] = l[lane + 64 * jj];
            const float m = wave_max(fmaxf(fmaxf(x4[0], x4[1]), fmaxf(x4[2], x4[3]))); float s = 0.f;
#pragma unroll
            for (int jj = 0; jj < 4; ++jj) { x4[jj] = __expf(x4[jj] - m); s += x4[jj]; }
            const float inv = 1.0f / wave_sum(s);
#pragma unroll
            for (int jj = 0; jj < 4; ++jj) l[lane + 64 * jj] = x4[jj] * inv;
        }
        __syncthreads();
        {
            float o0[4] = {0.f, 0.f, 0.f, 0.f}, o1[4] = {0.f, 0.f, 0.f, 0.f};
            const float* cv = F.cache_v() + (size_t)kvh * HD + 2 * lane; const bf16* nv = F.VB() + (size_t)(MP + 4 * b) * DKV + kvh * HD + 2 * lane;
#pragma unroll 1
            for (int jb = 0; jb < 4; ++jb) {
                f32x2 vv[16];
#pragma unroll
                for (int u = 0; u < 16; ++u) { const int rr = rid[64 * qt + 16 * jb + u];
                    if (rr >= 0) vv[u] = *(const f32x2*)(cv + (size_t)rr * (NKV * HD)); else { const unsigned w = *(const unsigned*)(nv + (size_t)(-rr - 1) * DKV); vv[u] = (f32x2){bflo(w), bfhi(w)}; } }
#pragma unroll
                for (int u = 0; u < 16; ++u)
#pragma unroll
                    for (int g = 0; g < 4; ++g) { const float p = lg[(4 * kvl + g) * 256 + 64 * qt + 16 * jb + u]; o0[g] += p * vv[u].x; o1[g] += p * vv[u].y; }
            }
#pragma unroll
            for (int g = 0; g < 4; ++g) *(LAS f32x2*)(op + ((kvl * 4 + qt) * 4 + g) * HD + 2 * lane) = (f32x2){o0[g], o1[g]};
        }
        __syncthreads();
        {
            const int lh = F.tid >> 6, kl = lh >> 2, g = lh & 3; float s0 = 0.f, s1 = 0.f;
#pragma unroll
            for (int q = 0; q < 4; ++q) { const f32x2 v = *(const LAS f32x2*)(op + ((kl * 4 + q) * 4 + g) * HD + 2 * lane); s0 += v.x; s1 += v.y; }
            *((unsigned*)(F.OB() + (size_t)(MP + r) * DQ + (8 * hp + lh) * HD) + lane) = pk2(s0, s1);
        }
    }
}

template <bool FIRST> __device__ __forceinline__ void ln_rows(Frame& F, const bf16* in, bf16* outb, f32x2* stats, float* outf, const float* g, const float* bta) {
    for (int m = F.gw; m < MALL; m += F.NGW) {
        const v4u* xr = (const v4u*)(in + (size_t)m * DM) + F.lane;
        f32x4 v[8]; float s = 0.f;
#pragma unroll
        for (int j = 0; j < 4; ++j) bf8_to_f(xr[64 * j], v[2 * j], v[2 * j + 1]);
#pragma unroll
        for (int j = 0; j < 8; ++j) s += (v[j][0] + v[j][1]) + (v[j][2] + v[j][3]);
        const float mean = wave_sum(s) * (1.f / DM); float s2 = 0.f;
#pragma unroll
        for (int j = 0; j < 8; ++j) { v[j] = v[j] - mean; s2 += (v[j][0] * v[j][0] + v[j][1] * v[j][1]) + (v[j][2] * v[j][2] + v[j][3] * v[j][3]); }
        const float rstd = 1.0f / sqrtf(wave_sum(s2) * (1.f / DM) + LN_EPS);
        const f32x4* gp = (const f32x4*)g + 2 * F.lane; const f32x4* bp = (const f32x4*)bta + 2 * F.lane;
#pragma unroll
        for (int j = 0; j < 4; ++j) { const f32x4 y0 = v[2 * j] * rstd * gp[128 * j] + bp[128 * j], y1 = v[2 * j + 1] * rstd * gp[128 * j + 1] + bp[128 * j + 1];
            if (FIRST) ((v4u*)(outb + (size_t)m * DM) + F.lane)[64 * j] = pk8v(y0, y1);
            else { f32x4* of = (f32x4*)(outf + (size_t)m * DM) + 2 * F.lane; __builtin_nontemporal_store(y0, of + 128 * j); __builtin_nontemporal_store(y1, of + 128 * j + 1); } }
        if (FIRST && F.lane == 0) stats[m] = (f32x2){mean, rstd};
    }
}
__device__ __forceinline__ void hc_fix(Frame& F) {
    const int gt = blockIdx.x * 512 + F.tid, NT_ = F.G * 512;
    constexpr int NFIX = (MP / 256 - NBATCH) * 2;
    for (int it = gt; it < (NFIX + MS) * (DFF / 8); it += NT_) {
        const int ri = it / (DFF / 8), f0 = (it % (DFF / 8)) * 8; const int pc = ((f0 >> 7) << 8) + (f0 & 127);
        int row; if (ri < NFIX) { const int k = ri >> 1; row = ((k / 7) * 8 + 1 + k % 7) * 256 + (ri & 1); } else row = MP + (ri - NFIX);
        float u2[8], u1[8], u0[8], gg[8], r[8];
        unpack8(*(const v4u*)(F.UG() + (size_t)row * NUG + pc), u2);
        unpack8(*(const v4u*)(F.UG() + (size_t)row * NUG + pc + 128), gg);
        if (row < MP) { const int t = row & (SEQ - 1);
            if (t >= 1) unpack8(*(const v4u*)(F.UG() + (size_t)(row - 1) * NUG + pc), u1); else {
#pragma unroll
                for (int e = 0; e < 8; ++e) u1[e] = 0.f; }
            if (t >= 2) unpack8(*(const v4u*)(F.UG() + (size_t)(row - 2) * NUG + pc), u0); else {
#pragma unroll
                for (int e = 0; e < 8; ++e) u0[e] = 0.f; }
        } else { const int r_ = row - MP, b = r_ >> 2, t = r_ & 3;
            if (t >= 1) unpack8(*(const v4u*)(F.UG() + (size_t)(row - 1) * NUG + pc), u1); else {
#pragma unroll
                for (int e = 0; e < 8; ++e) u1[e] = F.st_f()[(size_t)(b * 2 + 1) * DFF + f0 + e]; }
            if (t >= 2) unpack8(*(const v4u*)(F.UG() + (size_t)(row - 2) * NUG + pc), u0); else {
#pragma unroll
                for (int e = 0; e < 8; ++e) u0[e] = F.st_f()[(size_t)(b * 2 + t) * DFF + f0 + e]; }
        }
#pragma unroll
        for (int e = 0; e < 8; ++e) { const float cv = F.conv_f_w()[f0 + e] * u0[e] + F.conv_f_w()[DFF + f0 + e] * u1[e] + F.conv_f_w()[2 * DFF + f0 + e] * u2[e] + F.conv_f_b()[f0 + e]; r[e] = gelu_tanh(cv) * gg[e]; }
        *(v4u*)(F.HC() + (size_t)row * DFF + f0) = pack8(r);
    }
}

namespace att {
constexpr int D = 128, QSTR = 2048, KSTR = 512;
constexpr float THR = 8.f; constexpr bool WSKIP = false; constexpr int WINDOW = 1 << 30;
constexpr float SCALE = 0.08838834764831845f;
constexpr int NW = 8, QBLK = 32, KVBLK = 64, QB = NW * QBLK;
constexpr int SHM_V = KVBLK * D * 2, SHM_K = KVBLK * D * 2;
constexpr int ATT_LDS_BYTES = 2 * SHM_V + 2 * SHM_K + NW * 64 * 4;

typedef unsigned short bf16;
typedef short bf16x8 __attribute__((ext_vector_type(8)));
typedef short s16x4 __attribute__((ext_vector_type(4)));
typedef float f32x16 __attribute__((ext_vector_type(16)));
typedef float f32x4 __attribute__((ext_vector_type(4)));
typedef unsigned u32x4 __attribute__((ext_vector_type(4)));
template <class A, class Bt> struct same_t { static constexpr bool v = false; };
template <class A> struct same_t<A, A> { static constexpr bool v = true; };

#define KSWZ(row, colB) ((row) * 256 + ((colB) ^ (((row) & 7) << 4)))
#define SBAR() __builtin_amdgcn_sched_barrier(0)
__device__ __forceinline__ int v_st(int k, int c) { const int kk = (k & ~0xC) | ((k & 4) << 1) | ((k & 8) >> 1); return ((kk >> 3) * 4 + (c >> 5)) * 512 + ((kk & 7) * 32 + (c & 31)) * 2; }
__device__ __forceinline__ int v_rd_base(int lane) { return ((lane & 3) << 3) | (((lane >> 2) & 3) << 6) | (((lane >> 4) & 1) << 5) | (((lane >> 5) & 1) << 8); }
constexpr int v_rd_off(int d0, int ks, int half) { return d0 * 512 + ks * 4096 + half * 2048; }
__device__ __forceinline__ int crow(int r, int hi) { return (r & 3) + 8 * (r >> 2) + 4 * hi; }
__device__ __forceinline__ unsigned cvtpk(float lo, float hi) { return pg8::cvt_pk_bf16(lo, hi); }
__device__ __forceinline__ bf16x8 pack8(f32x4 a, f32x4 b) {
    u32x4 w = {cvtpk(a[0], a[1]), cvtpk(a[2], a[3]), cvtpk(b[0], b[1]), cvtpk(b[2], b[3])};
    return *reinterpret_cast<bf16x8*>(&w);
}
template <class T> __device__ __forceinline__ bf16x8 load8(const T* p) {
    if constexpr (same_t<T, float>::v) { return pack8(*(const f32x4*)p, *(const f32x4*)(p + 4)); }
    else { return *reinterpret_cast<const bf16x8*>(p); }
}
__device__ __forceinline__ void mask_tile(f32x16& p0, f32x16& p1, int dq, unsigned W) {
    const float NEG = -__builtin_inff();
#pragma unroll
    for (int r = 0; r < 16; ++r) {
        const int c = (r & 3) + 8 * (r >> 2);
        if ((unsigned)(dq - c) >= W) p0[r] = NEG;
        if ((unsigned)(dq - c - 32) >= W) p1[r] = NEG;
    }
}
__device__ __forceinline__ void mask_bits(f32x16& p0, f32x16& p1, unsigned long long mw, int hi) {
    const float NEG = -__builtin_inff();
    const unsigned w0 = (unsigned)mw >> (4 * hi), w1 = (unsigned)(mw >> 32) >> (4 * hi);
#pragma unroll
    for (int r = 0; r < 16; ++r) {
        const int c = (r & 3) + 8 * (r >> 2);
        if (((w0 >> c) & 1u) == 0u) p0[r] = NEG;
        if (((w1 >> c) & 1u) == 0u) p1[r] = NEG;
    }
}
__device__ __forceinline__ void partialSM(f32x16& p0, f32x16& p1, float& m_reg, float& mn, float& alpha) {
    float pmax = p0[0]; for (int r = 1; r < 16; ++r) pmax = fmaxf(pmax, p0[r]); for (int r = 0; r < 16; ++r) pmax = fmaxf(pmax, p1[r]);
    { auto rr = __builtin_amdgcn_permlane32_swap(__float_as_uint(pmax), __float_as_uint(pmax), false, false);
      pmax = fmaxf(__uint_as_float(rr[0]), __uint_as_float(rr[1])); }
    constexpr float C2 = 1.4426950408889634f * SCALE;
    if (__builtin_expect(__all((pmax - m_reg) * SCALE <= THR), 1)) { mn = m_reg; alpha = 1.f; }
    else { mn = fmaxf(m_reg, pmax); alpha = __builtin_amdgcn_exp2f((m_reg - mn) * C2); m_reg = mn; }
    const float mnL = -mn * C2;
    for (int r = 0; r < 16; ++r) p0[r] = fmaf(p0[r], C2, mnL); for (int r = 0; r < 16; ++r) p1[r] = fmaf(p1[r], C2, mnL);
    for (int r = 0; r < 16; ++r) p0[r] = __builtin_amdgcn_exp2f(p0[r]);
}
__device__ __forceinline__ void finishSM(f32x16& p0, f32x16& p1, float alpha, float& l_reg, bf16x8& pa0, bf16x8& pa1, bf16x8& pa2, bf16x8& pa3) {
    for (int r = 0; r < 16; ++r) p1[r] = __builtin_amdgcn_exp2f(p1[r]);
    float ps = 0; for (int r = 0; r < 16; ++r) ps += p0[r]; for (int r = 0; r < 16; ++r) ps += p1[r];
    { auto rr = __builtin_amdgcn_permlane32_swap(__float_as_uint(ps), __float_as_uint(ps), false, false);
      ps = __uint_as_float(rr[0]) + __uint_as_float(rr[1]); }
    l_reg = l_reg * alpha + ps;
#define PK4(P, B_, OUT) do { unsigned a0 = cvtpk(P[B_+0], P[B_+1]), a1 = cvtpk(P[B_+2], P[B_+3]);                          \
        unsigned b0 = cvtpk(P[B_+4], P[B_+5]), b1 = cvtpk(P[B_+6], P[B_+7]);                                             \
        auto r0 = __builtin_amdgcn_permlane32_swap(a0, b0, false, false); auto r1 = __builtin_amdgcn_permlane32_swap(a1, b1, false, false); \
        u32x4 w = {r0[0], r1[0], r0[1], r1[1]}; OUT = *reinterpret_cast<bf16x8*>(&w); } while (0)
    PK4(p0, 0, pa0); PK4(p0, 8, pa1); PK4(p1, 0, pa2); PK4(p1, 8, pa3);
#undef PK4
}
template <int KB, bool SK>
__device__ __forceinline__ void qkt(f32x16& p0, f32x16& p1, const char* K_lds, int r32, int hi, const bf16x8* qr, bool act) {
    if (SK && !act) { const float NEG = -__builtin_inff();
#pragma unroll
        for (int r = 0; r < 16; ++r) { p0[r] = NEG; p1[r] = NEG; } return; }
    p0 = f32x16{}; p1 = f32x16{};
    const char* kb[4];
#pragma unroll
    for (int dd = 0; dd < 4; ++dd) kb[dd] = K_lds + KB * SHM_K + KSWZ(r32, (dd * 16 + hi * 8) * 2);
#pragma unroll
    for (int d0 = 0; d0 < 8; ++d0) { const char* a = kb[d0 & 3] + (d0 >> 2) * 128;
        bf16x8 b0 = *reinterpret_cast<const bf16x8*>(a);
        bf16x8 b1 = *reinterpret_cast<const bf16x8*>(a + 32 * 256);
        p0 = __builtin_amdgcn_mfma_f32_32x32x16_bf16(b0, qr[d0], p0, 0, 0, 0);
        p1 = __builtin_amdgcn_mfma_f32_32x32x16_bf16(b1, qr[d0], p1, 0, 0, 0); }
}
template <int VB, bool SK>
__device__ __forceinline__ void pv_tile(f32x16* o, int vb0, bf16x8 pa0, bf16x8 pa1, bf16x8 pa2, bf16x8 pa3, bool act) {
    if (SK && !act) return;
#define TRRD(dst, off) asm volatile("ds_read_b64_tr_b16 %0, %1 offset:%2" : "=&v"(dst) : "v"(vb0), "i"(off) : "memory")
#define PV_D0(d0) do { s16x4 l0, l1, l2, l3, h0, h1, h2, h3; constexpr int b_ = VB * SHM_V + v_rd_off(d0, 0, 0);     \
        TRRD(l0, b_); TRRD(h0, b_ + 2048); TRRD(l1, b_ + 4096); TRRD(h1, b_ + 6144); TRRD(l2, b_ + 8192); TRRD(h2, b_ + 10240); TRRD(l3, b_ + 12288); TRRD(h3, b_ + 14336); \
        asm volatile("s_waitcnt lgkmcnt(0)" ::: "memory"); SBAR();                 \
        o[d0] = __builtin_amdgcn_mfma_f32_32x32x16_bf16(pa0, (bf16x8){l0[0], l0[1], l0[2], l0[3], h0[0], h0[1], h0[2], h0[3]}, o[d0], 0, 0, 0);   \
        o[d0] = __builtin_amdgcn_mfma_f32_32x32x16_bf16(pa1, (bf16x8){l1[0], l1[1], l1[2], l1[3], h1[0], h1[1], h1[2], h1[3]}, o[d0], 0, 0, 0);   \
        o[d0] = __builtin_amdgcn_mfma_f32_32x32x16_bf16(pa2, (bf16x8){l2[0], l2[1], l2[2], l2[3], h2[0], h2[1], h2[2], h2[3]}, o[d0], 0, 0, 0);   \
        o[d0] = __builtin_amdgcn_mfma_f32_32x32x16_bf16(pa3, (bf16x8){l3[0], l3[1], l3[2], l3[3], h3[0], h3[1], h3[2], h3[3]}, o[d0], 0, 0, 0); } while (0)
    PV_D0(0); PV_D0(1); PV_D0(2); PV_D0(3);
#undef PV_D0
#undef TRRD
}

template <class TIn, class TOut> struct BlockRef { const TIn* Q; const TIn* K; const TIn* V; TOut* O; const unsigned long long* MW; int P0; };
template <class TIn> struct Seam {
    bf16x8 qr[8];
    bf16x8 st_v0, st_v1, st_k0, st_k1; f32x4 sf0, sf1, sf2, sf3;
    f32x4 tq[16];
};
__device__ __forceinline__ int swa_jlo(int P0, int W) { const int lowk = P0 - W + 1; return lowk > 0 ? lowk / KVBLK : 0; }
#define ROW(p, k0, rr) ((p) + (unsigned)(((k0) + (rr)) * KSTR + sc))
#define VMW() asm volatile("s_waitcnt vmcnt(0)" ::: "memory")
#define VMWN(n) asm volatile("s_waitcnt vmcnt(%0)" :: "i"(n) : "memory")
#define SLOAD_H(Kp, Vp, k0) do { S.st_v0 = load8<TIn>(ROW(Vp, k0, sr)); S.st_v1 = load8<TIn>(ROW(Vp, k0, 32 + sr));              \
                         S.st_k0 = load8<TIn>(ROW(Kp, k0, sr)); S.st_k1 = load8<TIn>(ROW(Kp, k0, 32 + sr)); } while (0)
#define SWRITE_HK(bf) do { *(bf16x8*)(K_lds + (bf) * SHM_K + kws) = S.st_k0; *(bf16x8*)(K_lds + (bf) * SHM_K + kws + 32 * 256) = S.st_k1; } while (0)
#define SWRITE_HV(bf) do { *(bf16x8*)(V_lds + (bf) * SHM_V + vst0) = S.st_v0; *(bf16x8*)(V_lds + (bf) * SHM_V + vst1) = S.st_v1; } while (0)
#define SWRITE_H(bf) do { SWRITE_HV(bf); SWRITE_HK(bf); } while (0)
#define SLOAD_F(p, k0) do { S.sf0 = *(const f32x4*)ROW(p, k0, sr); S.sf1 = *(const f32x4*)(ROW(p, k0, sr) + 4);                \
                            S.sf2 = *(const f32x4*)ROW(p, k0, 32 + sr); S.sf3 = *(const f32x4*)(ROW(p, k0, 32 + sr) + 4); } while (0)
#define SWRITE_KF(bf) do { *(bf16x8*)(K_lds + (bf) * SHM_K + kws) = pack8(S.sf0, S.sf1); *(bf16x8*)(K_lds + (bf) * SHM_K + kws + 32 * 256) = pack8(S.sf2, S.sf3); } while (0)
#define SWRITE_VF(bf) do { *(bf16x8*)(V_lds + (bf) * SHM_V + vst0) = pack8(S.sf0, S.sf1); *(bf16x8*)(V_lds + (bf) * SHM_V + vst1) = pack8(S.sf2, S.sf3); } while (0)
template <class TIn, class TOut>
__device__ __forceinline__ void causal_swa_prime(const BlockRef<TIn, TOut>& cur, int W, char* lds, Seam<TIn>& S) {
    constexpr bool F32 = same_t<TIn, float>::v;
    const int tid = threadIdx.x, wid = __builtin_amdgcn_readfirstlane(tid >> 6), lane = tid & 63, r32 = lane & 31, hi = lane >> 5;
    const int sr = tid >> 4, sc = (tid & 15) * 8, kws = KSWZ(sr, sc * 2); char* K_lds = lds + 2 * SHM_V;
    const int kb0 = swa_jlo(cur.P0, W) * KVBLK;
    for (int d0 = 0; d0 < 8; ++d0) S.qr[d0] = load8<TIn>(cur.Q + (unsigned)((wid * QBLK + r32) * QSTR + d0 * 16 + hi * 8));
    if constexpr (F32) { SLOAD_F((const float*)cur.K, kb0); VMW(); SWRITE_KF(0); SBAR(); SLOAD_F((const float*)cur.V, kb0); }
    else { SLOAD_H(cur.K, cur.V, kb0); VMW(); SWRITE_HK(0); }
    __syncthreads();
}
template <class TIn, class TOut>
__device__ __forceinline__ void causal_swa_block(const BlockRef<TIn, TOut>& cur, const BlockRef<TIn, TOut>& nxt, int skv, int W, char* lds, Seam<TIn>& S) {
    constexpr bool F32 = same_t<TIn, float>::v;
    const int tid = threadIdx.x, wid = __builtin_amdgcn_readfirstlane(tid >> 6), lane = tid & 63, r32 = lane & 31, hi = lane >> 5;
    const int j_lo = swa_jlo(cur.P0, W);
    int j_hi = (cur.P0 + QB - 1) / KVBLK + 1; if (j_hi > skv / KVBLK) j_hi = skv / KVBLK;
    const int NT = j_hi - j_lo;
    const int kbn = swa_jlo(nxt.P0, W) * KVBLK;
    const int qlo = cur.P0 + wid * QBLK, qm = qlo + r32 - 4 * hi;
    char* V_lds = lds; char* K_lds = lds + 2 * SHM_V;
    float* ws = (float*)(lds + 2 * SHM_V + 2 * SHM_K) + wid * 64; float* li_l = ws, * al_l = ws + 32;
    float m_reg = -1e30f, l_reg = 0; f32x16 o[4] = {};
    const int sr = tid >> 4, sc = (tid & 15) * 8, vst0 = v_st(sr, sc), vst1 = v_st(32 + sr, sc), kws = KSWZ(sr, sc * 2);
    const int vb0 = (int)(uintptr_t)V_lds + v_rd_base(lane);
    const TIn* Kh = cur.K; const TIn* Vh = cur.V;
#define RESC(a) do { if (__any((a) < 1.f)) { if (hi == 0) al_l[r32] = (a); asm volatile("s_waitcnt lgkmcnt(0)" ::: "memory");              \
                     for (int d_ = 0; d_ < 4; ++d_) for (int r = 0; r < 16; ++r) o[d_][r] *= al_l[crow(r, hi)]; } } while (0)
#define KBASE(t) ((j_lo + (t)) * KVBLK)
#define ACT(t) (KBASE(t) <= qlo + QBLK - 1 && KBASE(t) + KVBLK - 1 >= qlo - W + 1)
#define MASKT(P0_, P1_, MW_) mask_bits(P0_, P1_, MW_, hi)
#define MWLOAD(t) (*(const unsigned long long*)(mlane + 8 * (j_lo + (t))))
    constexpr int NQL = F32 ? 16 : 8;
    constexpr bool SK = WSKIP && !F32;
#define SEAM_K0() do { VMWN(NQL); if constexpr (F32) { SWRITE_KF(0); SBAR(); SLOAD_F((const float*)nxt.V, kbn); } else { SWRITE_HK(0); } SBAR(); } while (0)
    f32x16 pA0, pA1, pB0, pB1; float mnA, mnB, alA, alB; bf16x8 pa0, pa1, pa2, pa3;
    char* M_lds = lds + ATT_LDS_BYTES + wid * 8192; const char* mlane = M_lds + r32 * 256; unsigned long long mwA, mwB; u32x4 mtmp[8];
    const u32x4* mg = (const u32x4*)(cur.MW + (size_t)(wid * QBLK) * 32) + lane;
    if constexpr (F32) { VMW(); SWRITE_VF(0); SBAR(); } else { SWRITE_HV(0); SBAR(); }
    if (NT > 1) { if constexpr (F32) SLOAD_F((const float*)Kh, KBASE(1)); else SLOAD_H(Kh, Vh, KBASE(1)); }
#pragma unroll
    for (int i = 0; i < 8; ++i) mtmp[i] = mg[64 * i];
    SBAR(); qkt<0, SK>(pA0, pA1, K_lds, r32, hi, S.qr, ACT(0));
    if constexpr (F32) { if (NT > 1) { VMW(); SWRITE_KF(1); SBAR(); SLOAD_F((const float*)Vh, KBASE(1)); } }
#pragma unroll
    for (int i = 0; i < 8; ++i) *((u32x4*)M_lds + lane + 64 * i) = mtmp[i];
    SBAR(); mwA = MWLOAD(0);
    MASKT(pA0, pA1, mwA); partialSM(pA0, pA1, m_reg, mnA, alA);
    if (NT > 1) { VMW(); if constexpr (F32) { SWRITE_VF(1); SBAR(); if (NT > 2) SLOAD_F((const float*)Kh, KBASE(2)); } else SWRITE_H(1); }
    __syncthreads();
#define HALF_STEP(PX0, PX1, mnX, alX, PY0, PY1, alY, t, KB, VB, SB, MWX) do {                                                 \
        SBAR(); qkt<KB, SK>(PX0, PX1, K_lds, r32, hi, S.qr, ACT(t));                                             \
        finishSM(PY0, PY1, alY, l_reg, pa0, pa1, pa2, pa3); SBAR();                                                           \
        if ((t) + 1 < NT) { if constexpr (F32) { VMW(); SWRITE_KF(SB); SBAR(); SLOAD_F((const float*)Vh, KBASE((t) + 1)); }  \
                            else { SLOAD_H(Kh, Vh, KBASE((t) + 1)); } SBAR(); }                                               \
        MWX = MWLOAD(t); pv_tile<VB, SK>(o, vb0, pa0, pa1, pa2, pa3, ACT((t) - 1)); MASKT(PX0, PX1, MWX); partialSM(PX0, PX1, m_reg, mnX, alX);                                        \
        __syncthreads();                                                                                                      \
        if ((t) + 1 < NT) { VMW(); if constexpr (F32) { SWRITE_VF(SB); SBAR(); if ((t) + 2 < NT) SLOAD_F((const float*)Kh, KBASE((t) + 2)); } \
                            else { SWRITE_H(SB); } }                                                                          \
        RESC(alX); __syncthreads(); } while (0)
    for (int t = 1; t + 1 < NT; t += 2) {
        HALF_STEP(pB0, pB1, mnB, alB, pA0, pA1, alA, t, 1, 0, 0, mwB);
        HALF_STEP(pA0, pA1, mnA, alA, pB0, pB1, alB, t + 1, 0, 1, 1, mwA);
    }
    const bool even = (NT & 1) == 0;
    if (even) { SBAR(); qkt<1, SK>(pB0, pB1, K_lds, r32, hi, S.qr, ACT(NT - 1)); SBAR(); }
#define QROW(e) (nxt.Q + (size_t)(wid * QBLK + r32) * QSTR + ((e) >> 1) * 16 + hi * 8 + ((e) & 1) * 4)
    if constexpr (F32) { SLOAD_F((const float*)nxt.K, kbn); SBAR();
#pragma unroll
        for (int e = 0; e < 8; ++e) S.tq[e] = *(const f32x4*)QROW(e); }
    else { SLOAD_H(nxt.K, nxt.V, kbn); SBAR();
#pragma unroll
        for (int d0 = 0; d0 < 8; ++d0) S.qr[d0] = load8<TIn>(nxt.Q + (unsigned)((wid * QBLK + r32) * QSTR + d0 * 16 + hi * 8)); }
    SBAR();
    finishSM(pA0, pA1, alA, l_reg, pa0, pa1, pa2, pa3); SBAR();
    if constexpr (F32) {
#pragma unroll
        for (int e = 8; e < 16; ++e) S.tq[e] = *(const f32x4*)QROW(e); SBAR(); }
#undef QROW
    pv_tile<0, SK>(o, vb0, pa0, pa1, pa2, pa3, ACT(even ? NT - 2 : NT - 1));
    if (even) { mwB = MWLOAD(NT - 1); MASKT(pB0, pB1, mwB); partialSM(pB0, pB1, m_reg, mnB, alB); __syncthreads(); RESC(alB);
        finishSM(pB0, pB1, alB, l_reg, pa0, pa1, pa2, pa3); SBAR(); pv_tile<1, SK>(o, vb0, pa0, pa1, pa2, pa3, ACT(NT - 1)); }
    SBAR(); SEAM_K0();
    if (hi == 0) li_l[r32] = l_reg; asm volatile("s_waitcnt lgkmcnt(0)" ::: "memory");
    int r32e = r32, hie = hi; asm volatile("" : "+v"(r32e), "+v"(hie));
    float rli[16];
#pragma unroll
    for (int r = 0; r < 16; ++r) rli[r] = __builtin_amdgcn_rcpf(li_l[crow(r, hie)]);
    TOut* Ow = cur.O + (size_t)(wid * QBLK) * QSTR;
#pragma unroll
    for (int r = 0; r < 16; ++r) { const int orow = crow(r, hie);
#pragma unroll
        for (int d0 = 0; d0 < 4; ++d0) { const float v = o[d0][r] * rli[r];
            if constexpr (same_t<TOut, float>::v) { Ow[(unsigned)(orow * QSTR + d0 * 32 + r32e)] = v; }
            else { const float vn = __shfl_xor(v, 1);
                   if ((r32e & 1) == 0) *(unsigned*)(Ow + (unsigned)(orow * QSTR + d0 * 32 + r32e)) = cvtpk(v, vn); } } }
    if constexpr (F32) {
#pragma unroll
        for (int d0 = 0; d0 < 8; ++d0) S.qr[d0] = pack8(S.tq[2 * d0], S.tq[2 * d0 + 1]); }
    __syncthreads();
#undef RESC
#undef KBASE
#undef ACT
#undef MASKT
#undef MWLOAD
#undef SEAM_K0
#undef HALF_STEP
}
#undef ROW
#undef VMW
#undef VMWN
#undef SLOAD_H
#undef SWRITE_HK
#undef SWRITE_HV
#undef SWRITE_H
#undef SLOAD_F
#undef SWRITE_KF
#undef SWRITE_VF


}

constexpr int SC_PITCH = 2064;
template <int NREG> __device__ __forceinline__ unsigned long long select_mask(const unsigned (&x)[NREG], int K, int lane) {
    unsigned tau = 0u; bool exact = false;
    for (int bit = 31; bit >= 0; --bit) {
        const unsigned cand = tau | (1u << bit); int c = 0;
#pragma unroll
        for (int i = 0; i < NREG; i += 8) {
            unsigned long long m0, m1, m2, m3, m4, m5, m6, m7;
            asm("v_cmp_ge_u32_e64 %0, %8, %16\n\tv_cmp_ge_u32_e64 %1, %9, %16\n\tv_cmp_ge_u32_e64 %2, %10, %16\n\tv_cmp_ge_u32_e64 %3, %11, %16\n\t"
                "v_cmp_ge_u32_e64 %4, %12, %16\n\tv_cmp_ge_u32_e64 %5, %13, %16\n\tv_cmp_ge_u32_e64 %6, %14, %16\n\tv_cmp_ge_u32_e64 %7, %15, %16"
                : "=&s"(m0), "=&s"(m1), "=&s"(m2), "=&s"(m3), "=&s"(m4), "=&s"(m5), "=&s"(m6), "=&s"(m7)
                : "v"(x[i]), "v"(x[i + 1]), "v"(x[i + 2]), "v"(x[i + 3]), "v"(x[i + 4]), "v"(x[i + 5]), "v"(x[i + 6]), "v"(x[i + 7]), "s"(cand));
            c += ((__popcll(m0) + __popcll(m1)) + (__popcll(m2) + __popcll(m3))) + ((__popcll(m4) + __popcll(m5)) + (__popcll(m6) + __popcll(m7)));
        }
        if (c >= K) { tau = cand; if (c == K) { exact = true; break; } }
    }
    unsigned long long mine = 0ull;
    if (exact) {
#pragma unroll
        for (int i = 0; i < NREG; ++i) { const unsigned long long ms = __ballot(x[i] >= tau); if (lane == i) mine = ms; }
        return mine;
    }
    int cgt = 0;
#pragma unroll
    for (int i = 0; i < NREG; ++i) cgt += __popcll(__ballot(x[i] > tau));
    const int need = K - cgt; int eqt = 0; const unsigned long long lt = (1ull << lane) - 1ull;
#pragma unroll
    for (int i = 0; i < NREG; ++i) {
        const bool gt = x[i] > tau, eq = (x[i] == tau) && (tau != 0u);
        const unsigned long long meq = __ballot(eq);
        const bool sel = gt || (eq && (eqt + __popcll(meq & lt)) < need);
        const unsigned long long ms = __ballot(sel);
        if (lane == i) mine = ms;
        eqt += __popcll(meq);
    }
    return mine;
}
template <int NREG> __device__ __forceinline__ unsigned long long select_query(const LAS float* Sq, int t, int ln) {
    float v[NREG]; unsigned x[NREG];
#pragma unroll
    for (int i = 0; i < NREG; ++i) v[i] = Sq[64 * i];
#pragma unroll
    for (int i = 0; i < NREG; ++i) x[i] = ln <= t - 64 * i ? sortable(v[i]) : 0u;
    return select_mask<NREG>(x, TOPK, ln);
}
__device__ __forceinline__ void idx_unit(Frame& F, int b, int qb) {
    LAS float* S = (LAS float*)F.lds;
    const int lane = F.lane, fr = lane & 15, fq = lane >> 4;
    const int q0 = b * SEQ + 16 * qb;
    bf16x8 bq[16][2]; float wq[16];
    {   const bf16* qp = F.IQB() + (size_t)(q0 + fr) * DIQ + 16 * fq;
#pragma unroll
        for (int h = 0; h < 16; ++h) { bq[h][0] = *(const bf16x8*)(qp + h * 64); bq[h][1] = *(const bf16x8*)(qp + h * 64 + 8); }
        const f32x4* wp = (const f32x4*)(F.IW() + (size_t)(q0 + fr) * NIH);
#pragma unroll
        for (int h4 = 0; h4 < 4; ++h4) { const f32x4 w = wp[h4]; wq[4 * h4] = w[0]; wq[4 * h4 + 1] = w[1]; wq[4 * h4 + 2] = w[2]; wq[4 * h4 + 3] = w[3]; }
    }
    const int nkb = qb + 1;
    const bf16* kbase = F.IKB() + (size_t)(b * SEQ + fr) * IDD + 16 * fq;
    bf16x8 a0, a1;
    if (F.wave < nkb) { a0 = *(const bf16x8*)(kbase + (size_t)(16 * F.wave) * IDD); a1 = *(const bf16x8*)(kbase + (size_t)(16 * F.wave) * IDD + 8); }
    for (int kb = F.wave; kb < nkb; kb += NWAVES) {
        const bf16x8 c0 = a0, c1 = a1;
        if (kb + NWAVES < nkb) { a0 = *(const bf16x8*)(kbase + (size_t)(16 * (kb + NWAVES)) * IDD); a1 = *(const bf16x8*)(kbase + (size_t)(16 * (kb + NWAVES)) * IDD + 8); }
        f32x4 tot = (f32x4){0.f, 0.f, 0.f, 0.f};
#pragma unroll
        for (int h = 0; h < 16; ++h) {
            f32x4 acc = __builtin_amdgcn_mfma_f32_16x16x32_bf16(c0, bq[h][0], (f32x4){0.f, 0.f, 0.f, 0.f}, 0, 0, 0);
            acc = __builtin_amdgcn_mfma_f32_16x16x32_bf16(c1, bq[h][1], acc, 0, 0, 0);
#pragma unroll
            for (int i = 0; i < 4; ++i) tot[i] += wq[h] * relu_i(acc[i]);
        }
        *(LAS f32x4*)(S + fr * SC_PITCH + 16 * kb + 4 * fq) = tot;
    }
    __syncthreads();
#pragma unroll 1
    for (int jq = 0; jq < 2; ++jq) {
        const int ql = 2 * F.wave + jq, t = 16 * qb + ql; unsigned long long mine;
        const int ln = opaque_v(lane); const LAS float* Sq = S + ql * SC_PITCH + ln;
        if (t < TOPK) mine = (lane < 32 && 64 * lane <= t) ? (t - 64 * lane >= 63 ? ~0ull : ((2ull << (t - 64 * lane)) - 1ull)) : 0ull;
        else if (t < 512) mine = select_query<8>(Sq, t, ln);
        else if (t < 1024) mine = select_query<16>(Sq, t, ln);
        else if (t < 1536) mine = select_query<24>(Sq, t, ln);
        else mine = select_query<32>(Sq, t, ln);
        if (lane < 32) F.MASK()[(size_t)(b * SEQ + t) * 32 + lane] = mine;
    }
    __syncthreads();
}
__device__ __forceinline__ void idx_phase(Frame& F) {
    const int c = blockIdx.x, slot = (c >> 3) % 5;
    bool pend = true;
    for (int k = 0;; ++k) {
        const int L = k * F.G + c; const bool more = L < NBATCH * 128;
        if (pend && (k == slot || !more)) { late_transposes(F); __syncthreads(); pend = false; }
        if (!more) break;
        int b, qb;
        if (F.G == 256) { b = c >> 5; const int r = c & 31; qb = k == 0 ? r : k == 1 ? 63 - r : k == 2 ? 64 + r : 127 - r; }
        else { b = L >> 7; qb = L & 127; }
        idx_unit(F, b, qb);
    }
}

typedef att::BlockRef<bf16, bf16> AttRef;
__device__ __forceinline__ AttRef att_ref(const Frame& F, int L, int pass) {
    const int bh = L >> 2, y = L & 3, b = bh >> 4, h = bh & 15, qb = pass ? 7 - y : y;
    AttRef r; const size_t row0 = (size_t)b * SEQ + (size_t)qb * 256;
    r.Q = F.QB() + row0 * DQ + h * HD; r.O = F.OB() + row0 * DQ + h * HD;
    r.K = F.KB() + (size_t)b * SEQ * DKV + (h >> 2) * HD; r.V = F.VB() + (size_t)b * SEQ * DKV + (h >> 2) * HD;
    r.MW = F.MASK() + row0 * 32; r.P0 = qb * 256;
    return r;
}
__device__ __forceinline__ void att_phase(Frame& F, char* lds) {
    constexpr int TOTAL = NBATCH * 16 * 4;
    int L = blockIdx.x; if (L >= TOTAL) return;
    int pass = 0;
    AttRef cur = att_ref(F, L, 0);
    att::Seam<bf16> S;
    att::causal_swa_prime<bf16, bf16>(cur, SEQ, lds, S);
    for (;;) {
        const bool more_pass = pass == 0, more_item = L + F.G < TOTAL, last = !more_pass && !more_item;
        int passn = pass + 1, Ln = L;
        if (!more_pass) { passn = 0; Ln = more_item ? L + F.G : L; }
        const AttRef nxt = last ? cur : att_ref(F, Ln, passn);
        att::causal_swa_block<bf16, bf16>(cur, nxt, SEQ, SEQ, lds, S);
        if (last) break;
        cur = nxt; pass = passn; L = Ln;
    }
}

__global__ void __launch_bounds__(NWAVES * 64, 2) hybrid_fwd(Args args) {
    extern __shared__ __attribute__((aligned(16))) unsigned char lds[];
    Frame F;
    F.lds = (LAS unsigned char*)lds;
    F.tid = threadIdx.x; F.lane = F.tid & 63; F.wave = __builtin_amdgcn_readfirstlane(F.tid >> 6);
    F.G = gridDim.x; F.gw = blockIdx.x * NWAVES + F.wave; F.NGW = F.G * NWAVES;
    F.a = (const Args CAS*)__builtin_amdgcn_kernarg_segment_ptr();
    unsigned char* ws = F.a->ws;
    for (int u = F.tid; u < (LDS_BYTES - LDSCTL_OFF) / 4; u += NWAVES * 64) ((LAS unsigned*)(F.lds + LDSCTL_OFF))[u] = 0u;
    __syncthreads();
    unsigned* barw = (unsigned*)(ws + WS_CTL) + CW_BAR;
    XcdBarrier bar; bar.bar = barw; bar.x = 0; bar.st = nullptr;
    if (MK_N_LAUNCHES == 1) bar = xcd_barrier_post(barw, (volatile LAS unsigned*)(F.lds + MISC_OFF) + 8);
    const int lo = F.a->ph_lo, hi = F.a->ph_hi;
#define IN(k) (lo <= (k) && (k) < hi)
#define SEAM(k) do { if (IN(k) && IN((k) + 1)) { if (MK_N_LAUNCHES == 1) xcd_barrier(bar); } } while (0)
    LAS unsigned char* ring = F.lds;

    if (IN(0)) { p0_prologue(F); }
    SEAM(0);
    if (IN(1)) {
        pg8::Gemm g{F.XB(), F.WIN(), MP, NZ, DM}; pg8::StaticOrder S; S.init(MP, NZ, F.G, (int)blockIdx.x);
        EpiZ E{F.CB(), F.CCH(), F.QB(), F.KB(), F.VB(), F.IQB(), F.SGA(), F.SGB(), F.out() + O_KP, F.out() + O_VP, F.out() + O_CAP, F.ROPEA(), F.ROPEB()};
        pg8::gemm_phase<EpiZ, pg8::StaticOrder, true, true>(ring, g, S, E);
        __syncthreads();
        ikiw_phase(F);
        skinny_gemm<3>(F, F.XB() + (size_t)MP * DM, F.WIN(), DM, NZ / 16, EpiRawF32{F.ZS(), NZ});
    }
    SEAM(1);
    if (IN(2)) { p2_pointwise(F); }
    SEAM(2);
    if (IN(3)) {
        pg8::Gemm g{F.A2(), F.WAOUT(), MP, DM, DCONV}; pg8::StaticOrder S; S.init(MP, DM, F.G, (int)blockIdx.x);
        EpiMerge<0> E{F.SGA(), nullptr, F.MA()};
        pg8::gemm_phase<EpiMerge<0>, pg8::StaticOrder, true, true>(ring, g, S, E);
        __syncthreads();
        skinny_gemm_half(F, F.A2() + (size_t)MP * DCONV, F.WAOUT(), DCONV, DM / 16, EpiRawF32{F.YAS(), DM});
        sample_scores(F);
        __syncthreads();
        idx_phase(F);
    }
    SEAM(3);
    if (IN(4)) {
        __syncthreads();
        sample_attend(F);
        __syncthreads();
        att_phase(F, (char*)lds);
    }
    SEAM(4);
    if (IN(5)) {
        pg8::Gemm g{F.OB(), F.WATTN(), MP, DM, DQ}; pg8::StaticOrder S; S.init(MP, DM, F.G, (int)blockIdx.x);
        EpiMerge<1> E{F.SGB(), F.MA(), F.MB()};
        pg8::gemm_phase<EpiMerge<1>, pg8::StaticOrder, true, true>(ring, g, S, E);
        __syncthreads();
        const bf16* sga = F.SGA() + (size_t)MP * DM; const bf16* sgb = F.SGB() + (size_t)MP * DM; const float* yas = F.YAS(); bf16* mb = F.MB() + (size_t)MP * DM;
        auto epi = [=](int r, int c, f32x4 v) { const size_t o = (size_t)r * DM + c; const v2u ga = *(const v2u*)(sga + o), gb = *(const v2u*)(sgb + o); const f32x4 ya = *(const f32x4*)(yas + o);
            v2u w; w.x = pk2(bflo(ga.x) * ya[0] + bflo(gb.x) * v[0], bfhi(ga.x) * ya[1] + bfhi(gb.x) * v[1]); w.y = pk2(bflo(ga.y) * ya[2] + bflo(gb.y) * v[2], bfhi(ga.y) * ya[3] + bfhi(gb.y) * v[3]); *(v2u*)(mb + o) = w; };
        skinny_gemm_half(F, F.OB() + (size_t)MP * DQ, F.WATTN(), DQ, DM / 16, epi);
    }
    SEAM(5);
    if (IN(6)) {
        pg8::Gemm g{F.MB(), F.WMIX(), MP, DM, DM}; pg8::StaticOrder S; S.init(MP, DM, F.G, (int)blockIdx.x);
        EpiPre1 E{F.x_p(), F.PRE1B()};
        pg8::gemm_phase<EpiPre1, pg8::StaticOrder, true, true>(ring, g, S, E);
        __syncthreads();
        const float* xs = F.x_s(); bf16* pre = F.PRE1B() + (size_t)MP * DM;
        auto epi = [=](int r, int c, f32x4 v) { const size_t o = (size_t)r * DM + c; const f32x4 y = *(const f32x4*)(xs + o) * ALPHA + v; v2u w; w.x = pk2(y[0], y[1]); w.y = pk2(y[2], y[3]); *(v2u*)(pre + o) = w; };
        skinny_gemm_half(F, F.MB() + (size_t)MP * DM, F.WMIX(), DM, DM / 16, epi);
    }
    SEAM(6);
    if (IN(7)) { ln_rows<true>(F, F.PRE1B(), F.X1B(), F.STATS(), nullptr, F.ln1g(), F.ln1b()); }
    SEAM(7);
    if (IN(8)) {
        pg8::Gemm g{F.X1B(), F.WUG(), MP, NUG, DM}; pg8::StaticOrder S; S.init(MP, NUG, F.G, (int)blockIdx.x);
        EpiHC E{F.UG(), F.HC(), F.out() + O_CFP, F.conv_f_w(), F.conv_f_b(), (LAS float*)(F.lds + HALO_OFF)};
        pg8::gemm_phase<EpiHC, pg8::StaticOrder, true, true>(ring, g, S, E);
        __syncthreads();
        bf16* ug = F.UG() + (size_t)MP * NUG; float* cfs = F.out() + O_CFS;
        auto epi = [=](int r, int c, f32x4 v) { v2u w; w.x = pk2(v[0], v[1]); w.y = pk2(v[2], v[3]); *(v2u*)(ug + (size_t)r * NUG + c) = w;
            const int t = r & 3; if ((c & 128) == 0 && t >= 2) *(f32x4*)(cfs + (size_t)((r >> 2) * 2 + (t - 2)) * DFF + ((c >> 8) << 7) + (c & 127)) = v; };
        skinny_gemm<3>(F, F.X1B() + (size_t)MP * DM, F.WUG(), DM, NUG / 16, epi);
    }
    SEAM(8);
    if (IN(9)) { hc_fix(F); }
    SEAM(9);
    if (IN(10)) {
        pg8::Gemm g{F.HC(), F.WDOWN(), MP, DM, DFF}; pg8::StaticOrder S; S.init(MP, DM, F.G, (int)blockIdx.x);
        EpiPre2 E{F.PRE1B(), F.STATS(), F.ln1g(), F.ln1b(), F.PRE2B()};
        pg8::gemm_phase<EpiPre2, pg8::StaticOrder, true, true>(ring, g, S, E);
        __syncthreads();
        const bf16* p1 = F.PRE1B() + (size_t)MP * DM; const f32x2* st = F.STATS() + MP; const float* lg_ = F.ln1g(); const float* lb_ = F.ln1b(); bf16* p2 = F.PRE2B() + (size_t)MP * DM;
        auto epi = [=](int r, int c, f32x4 v) { const size_t o = (size_t)r * DM + c; const v2u pw = *(const v2u*)(p1 + o); const f32x2 s_ = st[r]; const f32x4 gq = *(const f32x4*)(lg_ + c), bq_ = *(const f32x4*)(lb_ + c);
            f32x4 x; x[0] = bflo(pw.x); x[1] = bfhi(pw.x); x[2] = bflo(pw.y); x[3] = bfhi(pw.y); const f32x4 y = ((x - s_.x) * s_.y * gq + bq_) * ALPHA + v;
            v2u w; w.x = pk2(y[0], y[1]); w.y = pk2(y[2], y[3]); *(v2u*)(p2 + o) = w; };
        skinny_gemm_half(F, F.HC() + (size_t)MP * DFF, F.WDOWN(), DFF, DM / 16, epi);
    }
    SEAM(10);
    if (IN(11)) { ln_rows<false>(F, F.PRE2B(), nullptr, nullptr, F.out() + O_Y, F.ln2g(), F.ln2b()); }
#undef IN
#undef SEAM
}

extern "C" void kernel_launch(void* const* d_in, const int* in_sizes, int n_in, void* d_out, int out_size, void* d_ws, size_t ws_size, hipStream_t stream) {
    static int grid = 0;
    if (grid == 0) {
        if (n_in != 24 || out_size != (int)O_END || ws_size < WS_END) { fprintf(stderr, "kernel_launch: unexpected shapes (n_in %d, out %d, ws %zu); nothing launched\n", n_in, out_size, ws_size); grid = -1; return; }
        int dev = 0, cus = 0, per_cu = 0;
        if (hipGetDevice(&dev) != hipSuccess || hipDeviceGetAttribute(&cus, hipDeviceAttributeMultiprocessorCount, dev) != hipSuccess) { grid = -1; return; }
        if (hipFuncSetAttribute((const void*)hybrid_fwd, hipFuncAttributeMaxDynamicSharedMemorySize, LDS_BYTES) != hipSuccess) { fprintf(stderr, "kernel_launch: hipFuncSetAttribute failed\n"); grid = -1; return; }
        if (hipOccupancyMaxActiveBlocksPerMultiprocessor(&per_cu, (const void*)hybrid_fwd, NWAVES * 64, LDS_BYTES) != hipSuccess || per_cu < 1) { fprintf(stderr, "kernel_launch: occupancy query reports %d blocks per CU\n", per_cu); }
        (void)hipGetLastError();
        grid = cus;
    }
    if (grid < 0) return;
    (void)hipMemsetAsync((char*)d_ws + WS_CTL, 0, CTL_ZERO_BYTES, stream);
    Args a{};
    for (int i = 0; i < 24; ++i) a.in[i] = d_in[i];
    a.out = (float*)d_out; a.ws = (unsigned char*)d_ws;
    if (MK_N_LAUNCHES == 1) { a.ph_lo = 0; a.ph_hi = N_PHASES; hipLaunchKernelGGL(hybrid_fwd, dim3(grid), dim3(NWAVES * 64), LDS_BYTES, stream, a); }
    else for (int p = 0; p < N_PHASES; ++p) { a.ph_lo = p; a.ph_hi = p + 1; hipLaunchKernelGGL(hybrid_fwd, dim3(grid), dim3(NWAVES * 64), LDS_BYTES, stream, a); }
}
```
